# Optimizing an MI355X kernel written in HIP

```python
import jax, jax.numpy as jnp
from jax import lax
import numpy as np

D_MODEL = 1024
BATCH = 8
SEQ = 4096
DEPTH = 2

RET_HEADS = 8
RET_DK = 64
RET_DV = D_MODEL // RET_HEADS
RET_CHUNK = 128
RET_ROPE_BASE = 10000.0
ATT_HD = 64
ATT_HEADS = D_MODEL // ATT_HD
ATT_KV_HEADS = 4
WINDOW = 128
ATT_BLOCK = 128
ROPE_DIMS = ATT_HD // 4
ROPE_THETA = 500000.0
PEER_HEADS = 8
PEER_NKEYS = 128
PEER_EXPERTS = PEER_NKEYS * PEER_NKEYS
PEER_QDIM = 256
PEER_TOPK = 16
PEER_CHUNK = 128

EPS = 1e-6
NEG_INF = -1e30

kernel_name = "hybrid_retention_swa_peer_adaln"


def rmsnorm(x, g):
    xf = x.astype(jnp.float32)
    y = xf * lax.rsqrt(jnp.mean(xf * xf, axis=-1, keepdims=True) + EPS)
    return (y * g.astype(jnp.float32)).astype(x.dtype)


def rotary(t, positions, n_rot, base):
    half = n_rot // 2
    inv = jnp.power(base, -jnp.arange(half, dtype=jnp.float32) * (2.0 / n_rot))
    ang = positions.astype(jnp.float32)[..., None] * inv
    cos = jnp.cos(ang)[:, :, None, :].astype(t.dtype)
    sin = jnp.sin(ang)[:, :, None, :].astype(t.dtype)
    t1 = t[..., :half]
    t2 = t[..., half:n_rot]
    rot = jnp.concatenate([t1 * cos - t2 * sin, t2 * cos + t1 * sin], axis=-1)
    if n_rot == t.shape[-1]:
        return rot
    return jnp.concatenate([rot, t[..., n_rot:]], axis=-1)


def retention(q, k, v):
    B, S, H, dk = q.shape
    dv = v.shape[-1]
    C = RET_CHUNK
    N = S // C
    dt = q.dtype
    k = k * (dk ** -0.5)
    qc = q.reshape(B, N, C, H, dk)
    kc = k.reshape(B, N, C, H, dk)
    vc = v.reshape(B, N, C, H, dv)
    log_g = jnp.log(1.0 - jnp.power(2.0, -5.0 - jnp.arange(H, dtype=jnp.float32)))
    idx = jnp.arange(C, dtype=jnp.float32)
    diff = idx[:, None] - idx[None, :]
    decay = jnp.where(diff >= 0, jnp.exp(log_g[:, None, None] * jnp.maximum(diff, 0.0)), 0.0)
    scores = jnp.einsum('bnchd,bnmhd->bnhcm', qc, kc) * decay.astype(dt)
    inner = jnp.einsum('bnhcm,bnmhe->bnche', scores, vc)
    k_w = jnp.exp(log_g[:, None] * (C - 1.0 - idx)[None, :]).astype(dt)
    kv = jnp.einsum('bnmhd,bnmhe,hm->nbhde', kc, vc, k_w)
    chunk_decay = jnp.exp(log_g * C).astype(kv.dtype)[:, None, None]

    def step(state, kv_i):
        return state * chunk_decay + kv_i, state

    _, prev = lax.scan(step, jnp.zeros((B, H, dk, dv), kv.dtype), kv)
    q_w = jnp.exp(log_g[:, None] * (idx + 1.0)[None, :]).astype(dt)
    cross = jnp.einsum('bnchd,nbhde,hc->bnche', qc, prev, q_w)
    return (inner + cross).reshape(B, S, H, dv)


def head_groupnorm(o, g):
    B, S, H, dv = o.shape
    of = o.astype(jnp.float32)
    mu = jnp.mean(of, axis=-1, keepdims=True)
    var = jnp.mean(jnp.square(of - mu), axis=-1, keepdims=True)
    y = ((of - mu) * lax.rsqrt(var + EPS)).reshape(B, S, H * dv)
    return (y * g.astype(jnp.float32)).astype(o.dtype)


def sliding_window_attention(q, k, v, sinks):
    B, S, HQ, Dh = q.shape
    HKV = k.shape[2]
    G = HQ // HKV
    L = ATT_BLOCK
    N = S // L
    qb = (q * (Dh ** -0.5)).reshape(B, N, L, HKV, G, Dh)
    kb = k.reshape(B, N, L, HKV, Dh)
    vb = v.reshape(B, N, L, HKV, Dh)

    def with_prev(t):
        prev = jnp.concatenate([jnp.zeros_like(t[:, :1]), t[:, :-1]], axis=1)
        return jnp.concatenate([prev, t], axis=2)

    kk = with_prev(kb)
    vv = with_prev(vb)
    s = jnp.einsum('bnqhgd,bnkhd->bnhgqk', qb, kk).astype(jnp.float32)
    qi = jnp.arange(L)[:, None]
    ki = jnp.arange(2 * L)[None, :]
    rel = qi + L - ki
    kpos = jnp.arange(N)[:, None, None] * L - L + ki[None]
    valid = (rel >= 0)[None] & (rel < WINDOW)[None] & (kpos >= 0)
    s = jnp.where(valid[None, :, None, None], s, NEG_INF)
    sink = sinks.astype(jnp.float32).reshape(1, 1, HKV, G, 1, 1)
    m = jnp.maximum(jnp.max(s, axis=-1, keepdims=True), sink)
    p = jnp.exp(s - m)
    p = p / (jnp.sum(p, axis=-1, keepdims=True) + jnp.exp(sink - m))
    o = jnp.einsum('bnhgqk,bnkhd->bnqhgd', p.astype(v.dtype), vv)
    return o.reshape(B, S, HQ * Dh)


def token_mixer(h, positions, w_in, ret_gn_g, sinks, w_out):
    B, S, _ = h.shape
    widths = (RET_HEADS * RET_DK, RET_HEADS * RET_DK, RET_HEADS * RET_DV, RET_HEADS * RET_DV,
              ATT_HEADS * ATT_HD, ATT_KV_HEADS * ATT_HD, ATT_KV_HEADS * ATT_HD, D_MODEL, D_MODEL)
    cuts = [int(c) for c in np.cumsum(widths)[:-1]]
    proj = h @ w_in
    rq, rk, rv, rg, aq, ak, av, gate_a, gate_b = jnp.split(proj, cuts, axis=-1)
    rq = rotary(rq.reshape(B, S, RET_HEADS, RET_DK), positions, RET_DK, RET_ROPE_BASE)
    rk = rotary(rk.reshape(B, S, RET_HEADS, RET_DK), positions, RET_DK, RET_ROPE_BASE)
    ro = retention(rq, rk, rv.reshape(B, S, RET_HEADS, RET_DV))
    ya = head_groupnorm(ro, ret_gn_g) * jax.nn.silu(rg)
    aq = rotary(aq.reshape(B, S, ATT_HEADS, ATT_HD), positions, ROPE_DIMS, ROPE_THETA)
    ak = rotary(ak.reshape(B, S, ATT_KV_HEADS, ATT_HD), positions, ROPE_DIMS, ROPE_THETA)
    yb = sliding_window_attention(aq, ak, av.reshape(B, S, ATT_KV_HEADS, ATT_HD), sinks)
    merged = jax.nn.sigmoid(gate_a) * ya + jax.nn.sigmoid(gate_b) * yb
    return merged @ w_out


def peer(h, wq, k1, k2, u, v):
    B, S, D = h.shape
    H, K, half = PEER_HEADS, PEER_TOPK, PEER_QDIM // 2
    q = (h @ wq).reshape(B, S, H, PEER_QDIM)
    s1 = jnp.einsum('bshd,hnd->bshn', q[..., :half], k1).astype(jnp.float32)
    s2 = jnp.einsum('bshd,hnd->bshn', q[..., half:], k2).astype(jnp.float32)
    v1, i1 = lax.top_k(s1, K)
    v2, i2 = lax.top_k(s2, K)
    cand = (v1[..., :, None] + v2[..., None, :]).reshape(B, S, H, K * K)
    cand_idx = (i1[..., :, None] * PEER_NKEYS + i2[..., None, :]).reshape(B, S, H, K * K)
    top_s, pos = lax.top_k(cand, K)
    experts = jnp.take_along_axis(cand_idx, pos, axis=-1)
    gates = jax.nn.softmax(top_s, axis=-1).astype(h.dtype)
    n_chunk = (B * S) // PEER_CHUNK
    hx = h.reshape(n_chunk, PEER_CHUNK, D)
    ex = experts.reshape(n_chunk, PEER_CHUNK, H * K)
    gx = gates.reshape(n_chunk, PEER_CHUNK, H * K)

    def one_chunk(args):
        xc, ec, gc = args
        act = jax.nn.gelu(jnp.einsum('td,tkd->tk', xc, u[ec]), approximate=False)
        return jnp.einsum('tk,tkd->td', act * gc, v[ec])

    y = lax.map(one_chunk, (hx, ex, gx))
    return y.reshape(B, S, D)


def setup_inputs(seed: int = 0) -> dict:
    key = jax.random.key(seed)
    ks = jax.random.split(key, 18)
    D = D_MODEL
    in_w = 2 * RET_HEADS * RET_DK + 2 * RET_HEADS * RET_DV + ATT_HEADS * ATT_HD + 2 * ATT_KV_HEADS * ATT_HD + 2 * D
    nrm = jax.random.normal
    x = nrm(ks[0], (BATCH, SEQ, D), jnp.float32)
    c = nrm(ks[1], (BATCH, D), jnp.float32)
    positions = (jnp.arange(SEQ, dtype=jnp.int32)[None, :]
                 + jax.random.randint(ks[2], (BATCH, 1), 0, 1024, dtype=jnp.int32))
    ada_w = nrm(ks[3], (DEPTH, D, 6 * D), jnp.float32) * (0.2 * D ** -0.5)
    ada_b = nrm(ks[4], (DEPTH, 6 * D), jnp.float32) * 0.1
    norm1_g = 1.0 + 0.05 * nrm(ks[5], (DEPTH, D), jnp.float32)
    norm2_g = 1.0 + 0.05 * nrm(ks[6], (DEPTH, D), jnp.float32)
    w_in = nrm(ks[7], (DEPTH, D, in_w), jnp.float32) * D ** -0.5
    ret_gn_g = 1.0 + 0.05 * nrm(ks[8], (DEPTH, RET_HEADS * RET_DV), jnp.float32)
    sinks = 0.5 * nrm(ks[9], (DEPTH, ATT_HEADS), jnp.float32)
    w_out = nrm(ks[10], (DEPTH, D, D), jnp.float32) * D ** -0.5
    peer_wq = nrm(ks[11], (DEPTH, D, PEER_HEADS * PEER_QDIM), jnp.float32) * D ** -0.5
    peer_k1 = nrm(ks[12], (DEPTH, PEER_HEADS, PEER_NKEYS, PEER_QDIM // 2), jnp.float32) * (PEER_QDIM // 2) ** -0.5
    peer_k2 = nrm(ks[13], (DEPTH, PEER_HEADS, PEER_NKEYS, PEER_QDIM // 2), jnp.float32) * (PEER_QDIM // 2) ** -0.5
    peer_u = nrm(ks[14], (DEPTH, PEER_EXPERTS, D), jnp.float32) * D ** -0.5
    peer_v = nrm(ks[15], (DEPTH, PEER_EXPERTS, D), jnp.float32) * PEER_HEADS ** -0.5
    final_g = 1.0 + 0.05 * nrm(ks[16], (D,), jnp.float32)
    return {"x": x, "c": c, "positions": positions, "ada_w": ada_w, "ada_b": ada_b,
            "norm1_g": norm1_g, "norm2_g": norm2_g, "w_in": w_in, "ret_gn_g": ret_gn_g,
            "sinks": sinks, "w_out": w_out, "peer_wq": peer_wq, "peer_k1": peer_k1,
            "peer_k2": peer_k2, "peer_u": peer_u, "peer_v": peer_v, "final_g": final_g}


def reference(x, c, positions, ada_w, ada_b, norm1_g, norm2_g, w_in, ret_gn_g, sinks, w_out,
              peer_wq, peer_k1, peer_k2, peer_u, peer_v, final_g):
    cond = jax.nn.silu(c)
    for l in range(DEPTH):
        mod = cond @ ada_w[l] + ada_b[l]
        sh1, sc1, g1, sh2, sc2, g2 = jnp.split(mod, 6, axis=-1)
        h = rmsnorm(x, norm1_g[l]) * (1.0 + sc1[:, None]) + sh1[:, None]
        x = x + g1[:, None] * token_mixer(h, positions, w_in[l], ret_gn_g[l], sinks[l], w_out[l])
        h = rmsnorm(x, norm2_g[l]) * (1.0 + sc2[:, None]) + sh2[:, None]
        x = x + g2[:, None] * peer(h, peer_wq[l], peer_k1[l], peer_k2[l], peer_u[l], peer_v[l])
    return rmsnorm(x, final_g)
```

```cpp
#include <hip/hip_runtime.h>
#include <cstdio>
#include <cstdint>
#include <cmath>
namespace pg8 {
#define PG8_LAS __attribute__((address_space(3)))
typedef unsigned short bf16_t;
typedef short bf16x8 __attribute__((ext_vector_type(8)));
typedef float f32x4 __attribute__((ext_vector_type(4)));
typedef unsigned u32x4 __attribute__((ext_vector_type(4)));
constexpr int BM = 256, BK = 64, HALF = 128, HTB = HALF * BK * 2  , STAGE_BYTES = 8 * HTB, NXCD = 8, WGM = 8;

__host__ __device__ __forceinline__ int lds_byte(int r, int c) { const int st = (r >> 4) * 2 + (c >> 5), rr = r & 15, cc = c & 31, ob = rr * 64 + cc * 2; return st * 1024 + (ob ^ (((ob >> 9) & 1) << 5)); }
__host__ __device__ __forceinline__ void stage_rc(int b, int& R, int& C) { const int st = b / 1024, sb = b % 1024, swz = sb ^ (((sb >> 9) & 1) << 5); R = (st >> 1) * 16 + swz / 64; C = (st & 1) * 32 + (swz % 64) / 2; }
__host__ __device__ __forceinline__ int perm32(int rho) { const int n = rho >> 4, i = rho & 15; return 8 * (i >> 2) + 4 * n + (i & 3); }

struct Unit { int pm, pn; };
struct Gemm { const bf16_t* A; const bf16_t* Bt; int M, N, K; };

struct StaticOrder {
    int nM, nN, nwg, G, c;
    __host__ __device__ void init(int M, int N, int G_, int c_) { nM = M / BM; nN = N / BM; nwg = nM * nN; G = G_; c = c_; }
    __host__ __device__ bool next(int i, Unit& u) const {
        const long L = (long)i * G + c; if (L >= nwg) return false;
        int wgid = (int)L; { const int q = nwg / NXCD, r = nwg % NXCD, xcd = wgid % NXCD, off = wgid / NXCD; wgid = (xcd < r ? xcd * (q + 1) : r * (q + 1) + (xcd - r) * q) + off; }
        const int nig = WGM * nN, gid = wgid / nig, fm = gid * WGM, gsz = (nM - fm) < WGM ? (nM - fm) : WGM;
        u.pm = fm + ((wgid % nig) % gsz); u.pn = (wgid % nig) / gsz; return true;
    }
    __device__ __forceinline__ void a_ready(const Unit&) const {}
    __device__ __forceinline__ void done(const Unit&) const {}
};

__device__ __forceinline__ unsigned cvt_pk_bf16(float lo, float hi) { unsigned r; asm volatile("v_cvt_pk_bf16_f32 %0, %1, %2" : "=v"(r) : "v"(lo), "v"(hi)); return r; }
typedef float f32x2 __attribute__((ext_vector_type(2)));
struct EpiBf16 {
    static constexpr bool PERM = true, AFTER_DRAIN = false;
    bf16_t* O; int ldc;
    __device__ __forceinline__ void operator()(const f32x4 (&acc)[2][2][4][2], const Unit& u, int wr, int wc, int fr, int fq) const {
        const int row0 = u.pm * BM + wr * 64 + fr; const int col0 = u.pn * BM + wc * 32 + 8 * fq;
#pragma unroll
        for (int ai = 0; ai < 2; ++ai)
#pragma unroll
            for (int m = 0; m < 4; ++m) { bf16_t* rowp = O + (size_t)(row0 + ai * HALF + m * 16) * ldc + col0;
#pragma unroll
                for (int bj = 0; bj < 2; ++bj) { const f32x4 v0 = acc[ai][bj][m][0], v1 = acc[ai][bj][m][1];
                    u32x4 w; w.x = cvt_pk_bf16(v0[0], v0[1]); w.y = cvt_pk_bf16(v0[2], v0[3]); w.z = cvt_pk_bf16(v1[0], v1[1]); w.w = cvt_pk_bf16(v1[2], v1[3]);
                    *(u32x4*)(rowp + bj * HALF) = w; } }
    }
};
struct EpiResGate {
    static constexpr bool PERM = false, AFTER_DRAIN = false;
    const float* xin; float* xout; const float* gate; int gate_ld; int ldc;
    __device__ __forceinline__ void operator()(const f32x4 (&acc)[2][2][4][2], const Unit& u, int wr, int wc, int fr, int fq) const {
        const int col0 = u.pn * BM + wc * 32 + 4 * fq; const int b = (u.pm * BM) >> 12;
        f32x4 gv[2][2];
#pragma unroll
        for (int bj = 0; bj < 2; ++bj)
#pragma unroll
            for (int n = 0; n < 2; ++n) gv[bj][n] = *(const f32x4*)(gate + (size_t)b * gate_ld + col0 + bj * HALF + n * 16);
#pragma unroll
        for (int ai = 0; ai < 2; ++ai)
#pragma unroll
            for (int m = 0; m < 4; ++m) { const size_t off = (size_t)(u.pm * BM + ai * HALF + wr * 64 + m * 16 + fr) * ldc + col0;
#pragma unroll
                for (int bj = 0; bj < 2; ++bj)
#pragma unroll
                    for (int n = 0; n < 2; ++n) { const f32x4 xi = *(const f32x4*)(xin + off + bj * HALF + n * 16); *(f32x4*)(xout + off + bj * HALF + n * 16) = xi + gv[bj][n] * acc[ai][bj][m][n]; } }
    }
};
template <class Epi, class Sched, bool ALIGN_EPI = false, bool SP2 = false>
__device__ __forceinline__ void gemm_phase(PG8_LAS unsigned char* lds, const Gemm g, const Sched& S, const Epi& E) {
    const int tid = threadIdx.x, wid = __builtin_amdgcn_readfirstlane(tid >> 6), lane = tid & 63, wr = wid >> 2, wc = wid & 3, fr = lane & 15, fq = lane >> 4;
    const int K = g.K, nt = K / BK;
    unsigned voffA[2], voffB[2];
#pragma unroll
    for (int i = 0; i < 2; ++i) { int R, C; stage_rc(tid * 16 + i * 8192, R, C); const int Rb = Epi::PERM ? ((R & ~31) + perm32(R & 31)) : R;
        voffA[i] = (unsigned)(R * K + C) * 2u; voffB[i] = (unsigned)(Rb * K + C) * 2u; }
    const size_t kstep = (size_t)(BK * 2);
    const size_t hstep = (size_t)HALF * K * 2;
    const size_t tstep = 2 * hstep;
    const unsigned ldsw = (unsigned)wid * 1024u;
    const int aoff = lds_byte(wr * 64 + fr, fq * 8), boff = lds_byte(wc * 32 + fr, fq * 8);
#define PG8_SA(b, h) (((b) * 2 + (h)) * HTB)
#define PG8_SB(b, h) ((4 + (b) * 2 + (h)) * HTB)
#define PG8_STAGE(bufoff, gbase, voff) do { _Pragma("unroll") for (int _i = 0; _i < 2; ++_i) \
        __builtin_amdgcn_global_load_lds((const unsigned*)((const char*)(gbase) + (voff)[_i]), (PG8_LAS unsigned*)(lds + (bufoff) + ldsw + _i * 8192), 16, 0, 0); } while (0)
#define PG8_LDA(dst, b, h) do { _Pragma("unroll") for (int m = 0; m < 4; ++m) _Pragma("unroll") for (int k = 0; k < 2; ++k) dst[m][k] = *(const PG8_LAS bf16x8*)(lds + PG8_SA(b, h) + aoff + m * 2048 + k * 1024); } while (0)
#define PG8_LDB(dst, b, h) do { _Pragma("unroll") for (int n = 0; n < 2; ++n) _Pragma("unroll") for (int k = 0; k < 2; ++k) dst[n][k] = *(const PG8_LAS bf16x8*)(lds + PG8_SB(b, h) + boff + n * 2048 + k * 1024); } while (0)
#define PG8_MMA(ai, bj, At, Bt) do { __builtin_amdgcn_s_setprio(1); _Pragma("unroll") for (int m = 0; m < 4; ++m) _Pragma("unroll") for (int n = 0; n < 2; ++n) _Pragma("unroll") for (int k = 0; k < 2; ++k) \
        acc[ai][bj][m][n] = __builtin_amdgcn_mfma_f32_16x16x32_bf16(Bt[n][k], At[m][k], acc[ai][bj][m][n], 0, 0, 0); __builtin_amdgcn_s_setprio(0); } while (0)
#define PG8_WAIT_V(n) asm volatile("s_waitcnt vmcnt(" #n ")" ::: "memory")
#define PG8_WAIT_L(n) asm volatile("s_waitcnt lgkmcnt(" #n ")" ::: "memory")
#define PG8_BAR __builtin_amdgcn_s_barrier()
#define PG8_SCHED __builtin_amdgcn_sched_barrier(0)
    Unit cur, nxt; int ui = 0;
    if (!S.next(0, cur)) return;
    f32x4 acc[2][2][4][2];
#pragma unroll
    for (int a = 0; a < 2; ++a)
#pragma unroll
        for (int b = 0; b < 2; ++b)
#pragma unroll
            for (int m = 0; m < 4; ++m)
#pragma unroll
                for (int n = 0; n < 2; ++n) acc[a][b][m][n] = (f32x4){0.f, 0.f, 0.f, 0.f};
    bf16x8 At[4][2], B0[2][2], B1[2][2];
    const char* cA = (const char*)g.A + (size_t)cur.pm * tstep; const char* cB = (const char*)g.Bt + (size_t)cur.pn * tstep;
    S.a_ready(cur);
    if constexpr (SP2) {
        PG8_STAGE(PG8_SB(0, 0), cB, voffB); PG8_STAGE(PG8_SB(0, 1), cB + hstep, voffB); PG8_STAGE(PG8_SA(0, 0), cA, voffA); PG8_STAGE(PG8_SA(0, 1), cA + hstep, voffA);
        if (wr == 1) PG8_BAR;
        PG8_WAIT_V(2); PG8_BAR;
        PG8_STAGE(PG8_SB(1, 0), cB + kstep, voffB); PG8_STAGE(PG8_SA(1, 0), cA + kstep, voffA); PG8_STAGE(PG8_SB(1, 1), cB + hstep + kstep, voffB);
        PG8_WAIT_V(6); PG8_BAR;
    } else {
        PG8_STAGE(PG8_SB(0, 0), cB, voffB); PG8_STAGE(PG8_SA(0, 0), cA, voffA); PG8_STAGE(PG8_SB(0, 1), cB + hstep, voffB); PG8_STAGE(PG8_SA(0, 1), cA + hstep, voffA);
        if (wr == 1) PG8_BAR;
        PG8_WAIT_V(4); PG8_BAR;
        PG8_STAGE(PG8_SB(1, 0), cB + kstep, voffB); PG8_STAGE(PG8_SA(1, 0), cA + kstep, voffA); PG8_STAGE(PG8_SB(1, 1), cB + hstep + kstep, voffB);
        PG8_WAIT_V(6); PG8_BAR;
    }
    for (;;) {
        const bool has_next = S.next(ui + 1, nxt);
        const char* nA = has_next ? (const char*)g.A + (size_t)nxt.pm * tstep : cA; const char* nB = has_next ? (const char*)g.Bt + (size_t)nxt.pn * tstep : cB;
        for (int t = 0; t < nt; t += 2) {
            const bool last = (t == nt - 2);
            const char* a1 = cA + (size_t)(t + 1) * kstep;
            const char* a2 = last ? nA : cA + (size_t)(t + 2) * kstep; const char* b2 = last ? nB : cB + (size_t)(t + 2) * kstep;
            const char* a3 = a2 + kstep; const char* b3 = b2 + kstep;
            if (last && has_next) S.a_ready(nxt);
            if constexpr (SP2) {
            PG8_LDB(B0, 0, 0); PG8_LDB(B1, 0, 1); PG8_SCHED; PG8_LDA(At, 0, 0); PG8_STAGE(PG8_SA(1, 1), a1 + hstep, voffA);
            PG8_WAIT_V(8); PG8_WAIT_L(0); PG8_BAR; PG8_MMA(0, 0, At, B0); PG8_MMA(0, 1, At, B1); PG8_BAR; PG8_SCHED;
            PG8_LDA(At, 0, 1); PG8_STAGE(PG8_SB(0, 0), b2, voffB); PG8_STAGE(PG8_SB(0, 1), b2 + hstep, voffB); PG8_STAGE(PG8_SA(0, 0), a2, voffA);
            PG8_WAIT_V(8); PG8_WAIT_L(0); PG8_BAR; PG8_MMA(1, 0, At, B0); PG8_MMA(1, 1, At, B1); PG8_BAR; PG8_SCHED;
            PG8_LDB(B0, 1, 0); PG8_LDB(B1, 1, 1); PG8_SCHED; PG8_LDA(At, 1, 0); PG8_STAGE(PG8_SA(0, 1), a2 + hstep, voffA);
            PG8_WAIT_V(8); PG8_WAIT_L(0); PG8_BAR; PG8_MMA(0, 0, At, B0); PG8_MMA(0, 1, At, B1); PG8_BAR; PG8_SCHED;
            PG8_LDA(At, 1, 1); PG8_STAGE(PG8_SB(1, 0), b3, voffB); PG8_STAGE(PG8_SB(1, 1), b3 + hstep, voffB); PG8_STAGE(PG8_SA(1, 0), a3, voffA);
            PG8_WAIT_V(8); PG8_WAIT_L(0); PG8_BAR; PG8_MMA(1, 0, At, B0); PG8_MMA(1, 1, At, B1); PG8_BAR; PG8_SCHED;
            } else {
            PG8_LDB(B0, 0, 0); PG8_SCHED; PG8_LDA(At, 0, 0); PG8_STAGE(PG8_SA(1, 1), a1 + hstep, voffA);
            PG8_WAIT_L(8); PG8_BAR; PG8_WAIT_L(0); PG8_MMA(0, 0, At, B0); PG8_BAR; PG8_SCHED;
            PG8_LDB(B1, 0, 1); PG8_STAGE(PG8_SB(0, 0), b2, voffB);
            PG8_BAR; PG8_WAIT_L(0); PG8_MMA(0, 1, At, B1); PG8_BAR;
            PG8_LDA(At, 0, 1); PG8_STAGE(PG8_SA(0, 0), a2, voffA);
            PG8_BAR; PG8_WAIT_L(0); PG8_MMA(1, 0, At, B0); PG8_BAR; PG8_SCHED;
            PG8_STAGE(PG8_SB(0, 1), b2 + hstep, voffB);
            PG8_WAIT_V(6); PG8_BAR; PG8_MMA(1, 1, At, B1); PG8_BAR;
            PG8_LDB(B0, 1, 0); PG8_SCHED; PG8_LDA(At, 1, 0); PG8_STAGE(PG8_SA(0, 1), a2 + hstep, voffA);
            PG8_WAIT_L(8); PG8_BAR; PG8_WAIT_L(0); PG8_MMA(0, 0, At, B0); PG8_BAR; PG8_SCHED;
            PG8_LDB(B1, 1, 1); PG8_STAGE(PG8_SB(1, 0), b3, voffB);
            PG8_BAR; PG8_WAIT_L(0); PG8_MMA(0, 1, At, B1); PG8_BAR;
            PG8_LDA(At, 1, 1); PG8_STAGE(PG8_SA(1, 0), a3, voffA);
            PG8_BAR; PG8_WAIT_L(0); PG8_MMA(1, 0, At, B0); PG8_BAR; PG8_SCHED;
            PG8_STAGE(PG8_SB(1, 1), b3 + hstep, voffB);
            PG8_WAIT_V(6); PG8_BAR; PG8_MMA(1, 1, At, B1); PG8_BAR;
            }
        }
        if constexpr (ALIGN_EPI) { if (wr == 0) PG8_BAR; }
        if constexpr (!Epi::AFTER_DRAIN) { E(acc, cur, wr, wc, fr, fq); S.done(cur); }
        if (!has_next) break;
#pragma unroll
        for (int a = 0; a < 2; ++a)
#pragma unroll
            for (int b = 0; b < 2; ++b)
#pragma unroll
                for (int m = 0; m < 4; ++m)
#pragma unroll
                    for (int n = 0; n < 2; ++n) acc[a][b][m][n] = (f32x4){0.f, 0.f, 0.f, 0.f};
        cur = nxt; cA = nA; cB = nB; ++ui;
        if constexpr (ALIGN_EPI) { if (wr == 1) PG8_BAR; }
    }
    PG8_WAIT_V(0);
    if constexpr (!ALIGN_EPI) { if (wr == 0) PG8_BAR; }
    PG8_BAR;
    if constexpr (Epi::AFTER_DRAIN) { E.fused(acc, cur, wr, wc, fr, fq, lds, wid, lane); S.done(cur); }
#undef PG8_SA
#undef PG8_SB
#undef PG8_STAGE
#undef PG8_LDA
#undef PG8_LDB
#undef PG8_MMA
#undef PG8_WAIT_V
#undef PG8_WAIT_L
#undef PG8_BAR
#undef PG8_SCHED
}
}
#define PG8_SP2 true
#define PG8_ALIGN true
#define GAS __attribute__((address_space(1)))
#define LAS __attribute__((address_space(3)))
typedef unsigned short bf16;
typedef unsigned v4u __attribute__((ext_vector_type(4)));
typedef float f32x4 __attribute__((ext_vector_type(4)));
typedef short bf16x8 __attribute__((ext_vector_type(8)));
typedef GAS unsigned gu32;
typedef GAS unsigned long long gu64;
#define RLX_AGENT __ATOMIC_RELAXED, __HIP_MEMORY_SCOPE_AGENT
#define LDS_WAIT() asm volatile("s_waitcnt lgkmcnt(0)" ::: "memory")
#define VM_WAIT() asm volatile("s_waitcnt vmcnt(0)" ::: "memory")
__device__ __forceinline__ unsigned long long rt() { return __builtin_amdgcn_s_memrealtime(); }
__device__ __forceinline__ unsigned f2bf(float f) { unsigned u = __builtin_bit_cast(unsigned, f); return (u + 0x7fffu + ((u >> 16) & 1u)) >> 16; }
__device__ __forceinline__ unsigned pk2(float lo, float hi) { return f2bf(lo) | (f2bf(hi) << 16); }
#define XB_TMO      128
#define XB_XCNT(j)  (256  + 64 * (j))
#define XB_XSUB(j)  (1280 + 64 * (j))
#define XB_XGEN(j)  (2304 + 64 * (j))
#define XB_TOP      3328
#define XB_TOPGEN   3392
#define XCD_BAR_WORDS 3456
#define XB_SPIN_CAP (1u << 18)

__device__ __forceinline__ unsigned xb_ld(unsigned* p)              { return __hip_atomic_load(p, __ATOMIC_RELAXED, __HIP_MEMORY_SCOPE_AGENT); }
__device__ __forceinline__ unsigned xb_add(unsigned* p, unsigned v) { return __hip_atomic_fetch_add(p, v, __ATOMIC_RELAXED, __HIP_MEMORY_SCOPE_AGENT); }
__device__ __forceinline__ unsigned xb_xcc_id() { return (unsigned)__builtin_amdgcn_s_getreg((3 << 11) | 20) & 0xFu; }
#define XB_SPIN(cond, bar) do { unsigned _sp = 0; while (cond) { __builtin_amdgcn_s_sleep(1); \
    if ((++_sp & 255u) == 0u) { if (xb_ld(&(bar)[XB_TMO])) break; if (_sp > XB_SPIN_CAP) { atomicAdd(&(bar)[XB_TMO], 1u); break; } } } } while (0)

struct XcdBarrier {
    unsigned* bar; unsigned x;
    volatile LAS unsigned* st;
};

__device__ __forceinline__ XcdBarrier xcd_barrier_post(unsigned* bar, volatile LAS unsigned* st) {
    XcdBarrier b; b.bar = bar; b.x = xb_xcc_id(); b.st = st;
    if (threadIdx.x == 0) (void)xb_add(&bar[XB_XCNT(b.x)], 1u);
    return b;
}
__device__ __forceinline__ void xcd_barrier_complete(unsigned* bar, unsigned x, unsigned& nloc, unsigned& nx) {
    const unsigned G = gridDim.x * gridDim.y * gridDim.z;
    unsigned sum, cnt, mine, sp = 0u;
    for (;;) {
        sum = 0u; cnt = 0u; mine = 0u;
#pragma unroll
        for (unsigned j = 0; j < 16; ++j) { const unsigned c = xb_ld(&bar[XB_XCNT(j)]); sum += c; cnt += (c > 0u) ? 1u : 0u; mine = (j == x) ? c : mine; }
        if (sum == G) break;
        __builtin_amdgcn_s_sleep(1);
        if ((++sp & 255u) == 0u) { if (xb_ld(&bar[XB_TMO])) break; if (sp > XB_SPIN_CAP) { atomicAdd(&bar[XB_TMO], 1u); break; } }
    }
    nloc = mine > 0u ? mine : 1u; nx = cnt > 0u ? cnt : 1u;
}

__device__ __forceinline__ void xcd_barrier(const XcdBarrier& b) {
    asm volatile("s_waitcnt vmcnt(0)" ::: "memory");
    __syncthreads();
    if (threadIdx.x == 0) {
        unsigned* bar = b.bar;
        __builtin_amdgcn_s_waitcnt(0);
        unsigned nloc = b.st[0], nx = b.st[1];
        if (nloc == 0u) { xcd_barrier_complete(bar, b.x, nloc, nx); b.st[0] = nloc; b.st[1] = nx; }
        const unsigned old = xb_add(&bar[XB_XSUB(b.x)], 1u);
        const unsigned gen = old / nloc;
        if (old + 1u == (gen + 1u) * nloc) {
            __builtin_amdgcn_fence(__ATOMIC_RELEASE, "agent");
            asm volatile("s_waitcnt vmcnt(0)" ::: "memory");
            const unsigned og = xb_add(&bar[XB_TOP], 1u);
            const unsigned tg = og / nx;
            if (og + 1u == (tg + 1u) * nx) xb_add(&bar[XB_TOPGEN], 1u);
            else XB_SPIN(xb_ld(&bar[XB_TOPGEN]) == tg, bar);
            __builtin_amdgcn_fence(__ATOMIC_ACQUIRE, "agent");
            xb_add(&bar[XB_XGEN(b.x)], 1u);
            asm volatile("s_waitcnt vmcnt(0)" ::: "memory");
        } else {
            XB_SPIN(xb_ld(&bar[XB_XGEN(b.x)]) == gen, bar);
            __builtin_amdgcn_fence(__ATOMIC_ACQUIRE, "agent");
            asm volatile("s_waitcnt vmcnt(0)" ::: "memory");
        }
    }
    __syncthreads();
}
constexpr int NWAVES = 8, NTHR = 512;
constexpr int BATCH = 8, SEQ = 4096, D = 1024, M = BATCH * SEQ, DEPTH = 2;
constexpr int NIN = 6656, NA = 4096, NB = 2560;
constexpr int PA_RQ = 0, PA_RK = 512, PA_RV = 1024, PA_RG = 2048, PA_GA = 3072;
constexpr int PB_AQ = 0, PB_AK = 1024, PB_AV = 1280, PB_GB = 1536;
constexpr int NQP = 2048, NEXP = 16384, MODW = 6144;
constexpr float EPS = 1e-6f;
constexpr size_t MiB = 1u << 20;
constexpr size_t WS_CTL = 0, CTL_ZERO_BYTES = 1 * MiB;
constexpr size_t WS_MOD = 1 * MiB;
constexpr size_t WS_ROPE_R = 2 * MiB;
constexpr size_t WS_ROPE_A = 10 * MiB;
constexpr size_t WS_WIN = 12 * MiB;
constexpr size_t WS_WOUT = 38 * MiB;
constexpr size_t WS_WQ = 42 * MiB;
constexpr size_t WS_K1 = 50 * MiB;
constexpr size_t WS_K2 = WS_K1 + 512 * 1024;
constexpr size_t WS_XN = 52 * MiB;
constexpr size_t WS_MERGED = 116 * MiB;
constexpr size_t WS_PROJ = 180 * MiB;
constexpr size_t WS_QP = WS_PROJ, WS_IDX = WS_PROJ + 128 * MiB, WS_GATE = WS_PROJ + 144 * MiB, WS_VB = WS_PROJ + 160 * MiB;
constexpr size_t WS_END = 436 * MiB;
constexpr int CW_BAR = 4096;
constexpr int SCR_BYTES = 147456;
constexpr int LDSCTL_OFF = SCR_BYTES, LDS_BYTES = SCR_BYTES + 1024;

typedef float f32x2v __attribute__((ext_vector_type(2)));
struct Args { const float* in[17]; float* out; unsigned char* ws; int ph_lo, ph_hi, li, pad; };
__device__ const float INV_R[32] = {1.000000000e+00f, 7.498942614e-01f, 5.623413324e-01f, 4.216965139e-01f, 3.162277639e-01f, 2.371373773e-01f, 1.778279394e-01f, 1.333521307e-01f, 1.000000015e-01f, 7.498941571e-02f, 5.623413250e-02f, 4.216965288e-02f, 3.162277490e-02f, 2.371373773e-02f, 1.778279431e-02f, 1.333521493e-02f, 9.999999776e-03f, 7.498941850e-03f, 5.623413250e-03f, 4.216964822e-03f, 3.162277630e-03f, 2.371373586e-03f, 1.778279431e-03f, 1.333521446e-03f, 1.000000047e-03f, 7.498942432e-04f, 5.623413017e-04f, 4.216965172e-04f, 3.162277571e-04f, 2.371373703e-04f, 1.778279402e-04f, 1.333521504e-04f};
__device__ const float INV_A[8] = {1.000000000e+00f, 1.939227432e-01f, 3.760603070e-02f, 7.292664610e-03f, 1.414213562e-03f, 2.742481884e-04f, 5.318296098e-05f, 1.031338616e-05f};

__device__ __forceinline__ float bflo(unsigned w) { return __builtin_bit_cast(float, w << 16); }
__device__ __forceinline__ float bfhi(unsigned w) { return __builtin_bit_cast(float, w & 0xffff0000u); }
__device__ __forceinline__ float bf2f(unsigned short h) { return __builtin_bit_cast(float, (unsigned)h << 16); }
__device__ __forceinline__ void unpack8(const v4u w, float* f) { f[0] = bflo(w.x); f[1] = bfhi(w.x); f[2] = bflo(w.y); f[3] = bfhi(w.y); f[4] = bflo(w.z); f[5] = bfhi(w.z); f[6] = bflo(w.w); f[7] = bfhi(w.w); }
__device__ __forceinline__ float wave_sum(float v) {
#pragma unroll
    for (int o = 1; o < 64; o <<= 1) v += __shfl_xor(v, o);
    return v;
}
__device__ __forceinline__ float wave_max(float v) {
#pragma unroll
    for (int o = 1; o < 64; o <<= 1) v = fmaxf(v, __shfl_xor(v, o));
    return v;
}
__device__ __forceinline__ void wave_argmax(float& v, int& i) {
#pragma unroll
    for (int o = 1; o < 64; o <<= 1) { const float ov = __shfl_xor(v, o); const int oi = __shfl_xor(i, o); if (ov > v || (ov == v && oi < i)) { v = ov; i = oi; } }
}
__device__ __forceinline__ float sigmoidf_(float x) { return 1.f / (1.f + __expf(-x)); }
__device__ __forceinline__ float siluf_(float x) { return x / (1.f + __expf(-x)); }
__device__ __forceinline__ float rl_f(float v, int k) { return __builtin_bit_cast(float, __builtin_amdgcn_readlane(__builtin_bit_cast(int, v), k)); }
__device__ __forceinline__ int rl_i(int v, int k) { return __builtin_amdgcn_readlane(v, k); }

__device__ __forceinline__ void p0_transpose_item(const float* W, int K, int N, bf16* WT, int mode, LAS float* scr, int item, int lane) {
    const int nblk = N / 32, kb = item / nblk, nb = item % nblk, k0 = 64 * kb, n0 = 32 * nb;
    int d0 = n0;
    if (mode == 1) { if (n0 >= 3072 && n0 < 4608) d0 = n0 + 1024; else if (n0 >= 4608 && n0 < 5632) d0 = n0 - 1536; }
#pragma unroll 8
    for (int i = 0; i < 32; ++i) { const int kk = 2 * i + (lane >> 5); scr[kk * 33 + (lane & 31)] = W[(size_t)(k0 + kk) * N + n0 + (lane & 31)]; }
    LDS_WAIT(); asm volatile("" ::: "memory");
    const int c = lane & 7;
#pragma unroll
    for (int j = 0; j < 4; ++j) { const int n = (lane >> 3) + 8 * j; const LAS float* s = scr + (8 * c) * 33 + n;
        v4u o; o.x = pk2(s[0 * 33], s[1 * 33]); o.y = pk2(s[2 * 33], s[3 * 33]); o.z = pk2(s[4 * 33], s[5 * 33]); o.w = pk2(s[6 * 33], s[7 * 33]);
        *(GAS v4u*)(WT + (size_t)(d0 + n) * K + k0 + 8 * c) = o; }
    LDS_WAIT(); asm volatile("" ::: "memory");
}
__device__ __forceinline__ void cvt_f32_bf16(const float* src, bf16* dst, size_t n8, size_t g0, size_t gstride) {
    for (size_t i = g0; i < n8; i += gstride) { const f32x4 a = *(const GAS f32x4*)(src + i * 8), b = *(const GAS f32x4*)(src + i * 8 + 4);
        v4u o; o.x = pk2(a.x, a.y); o.y = pk2(a.z, a.w); o.z = pk2(b.x, b.y); o.w = pk2(b.z, b.w); *(GAS v4u*)(dst + i * 8) = o; }
}
__device__ __forceinline__ void phase_prologue(const Args& a, LAS unsigned char* lds, int vcu, int G, int tid) {
    const int lane = tid & 63, wave = __builtin_amdgcn_readfirstlane(tid >> 6);
    unsigned char* ws = a.ws;
    if (vcu < 192) {
        LAS float* cond = (LAS float*)lds; LAS float* red = (LAS float*)(lds + 32768);
        const float* c = a.in[1];
        for (int i = tid; i < BATCH * D; i += NTHR) { const float v = c[i]; cond[i] = v / (1.f + expf(-v)); }
        __syncthreads();
        const int l = vcu / 96, j0 = (vcu % 96) * 64, col = tid & 63, ks = tid >> 6;
        const float* W = a.in[3] + (size_t)l * D * MODW + j0 + col;
        float acc[8];
#pragma unroll
        for (int b = 0; b < 8; ++b) acc[b] = 0.f;
        for (int k = ks * 128; k < ks * 128 + 128; ++k) { const float w = W[(size_t)k * MODW];
#pragma unroll
            for (int b = 0; b < 8; ++b) acc[b] += cond[b * D + k] * w; }
#pragma unroll
        for (int b = 0; b < 8; ++b) red[(ks * 8 + b) * 64 + col] = acc[b];
        __syncthreads();
        { const int b = tid >> 6; float s = 0.f;
#pragma unroll
          for (int k2 = 0; k2 < 8; ++k2) s += red[(k2 * 8 + b) * 64 + col];
          s += a.in[4][l * MODW + j0 + col];
          ((float*)(ws + WS_MOD))[(size_t)(l * 8 + b) * MODW + j0 + col] = s; }
        __syncthreads();
    }
    {
        LAS float* scr = (LAS float*)(lds + 49152 + wave * 8448);
        const int gw = vcu * NWAVES + wave, NGW = G * NWAVES;
        constexpr int I_IN = (D / 64) * (NIN / 32), I_OUT = (D / 64) * (D / 32), I_Q = (D / 64) * (NQP / 32), I_L = I_IN + I_OUT + I_Q;
        for (int it = gw; it < 2 * I_L; it += NGW) {
            const int l = it / I_L; int r = it % I_L;
            if (r < I_IN) { p0_transpose_item(a.in[7] + (size_t)l * D * NIN, D, NIN, (bf16*)(ws + WS_WIN) + (size_t)l * NIN * D, 1, scr, r, lane); continue; } r -= I_IN;
            if (r < I_OUT) { p0_transpose_item(a.in[10] + (size_t)l * D * D, D, D, (bf16*)(ws + WS_WOUT) + (size_t)l * D * D, 0, scr, r, lane); continue; } r -= I_OUT;
            p0_transpose_item(a.in[11] + (size_t)l * D * NQP, D, NQP, (bf16*)(ws + WS_WQ) + (size_t)l * NQP * D, 0, scr, r, lane);
        }
    }
    const size_t gt = (size_t)vcu * NTHR + tid, GT = (size_t)G * NTHR;
    cvt_f32_bf16(a.in[12], (bf16*)(ws + WS_K1), (size_t)2 * 8 * 128 * 128 / 8, gt, GT);
    cvt_f32_bf16(a.in[13], (bf16*)(ws + WS_K2), (size_t)2 * 8 * 128 * 128 / 8, gt, GT);
    {
        const int* pos = (const int*)a.in[2];
        f32x2v* tr = (f32x2v*)(ws + WS_ROPE_R); f32x2v* ta = (f32x2v*)(ws + WS_ROPE_A);
        for (size_t idx = gt; idx < (size_t)M * 32; idx += GT) { const int m = (int)(idx >> 5), i = (int)(idx & 31);
            const float ang = (float)pos[m] * INV_R[i]; const double t = (double)ang * 0.15915494309189535; const float r = (float)(t - rint(t));
            tr[idx] = (f32x2v){__builtin_amdgcn_cosf(r), __builtin_amdgcn_sinf(r)}; }
        for (size_t idx = gt; idx < (size_t)M * 8; idx += GT) { const int m = (int)(idx >> 3), i = (int)(idx & 7);
            const float ang = (float)pos[m] * INV_A[i]; const double t = (double)ang * 0.15915494309189535; const float r = (float)(t - rint(t));
            ta[idx] = (f32x2v){__builtin_amdgcn_cosf(r), __builtin_amdgcn_sinf(r)}; }
    }
}

__device__ __forceinline__ void norm_row_bf16(const float* xrow, const float* g, const float* sc, const float* sh, bf16* orow, int lane) {
    const GAS f32x4* xr = (const GAS f32x4*)xrow + lane;
    f32x4 v[4]; float s = 0.f;
#pragma unroll
    for (int j = 0; j < 4; ++j) { v[j] = xr[64 * j]; s += (v[j].x * v[j].x + v[j].y * v[j].y) + (v[j].z * v[j].z + v[j].w * v[j].w); }
    const float rstd = rsqrtf(wave_sum(s) * (1.f / D) + EPS);
    GAS unsigned long long* o8 = (GAS unsigned long long*)orow + lane;
#pragma unroll
    for (int j = 0; j < 4; ++j) { const f32x4 gg = ((const GAS f32x4*)g)[lane + 64 * j], cc = ((const GAS f32x4*)sc)[lane + 64 * j], hh = ((const GAS f32x4*)sh)[lane + 64 * j];
        const f32x4 y = (v[j] * rstd * gg) * (cc + 1.0f) + hh;
        o8[64 * j] = (unsigned long long)pk2(y.x, y.y) | ((unsigned long long)pk2(y.z, y.w) << 32); }
}
__device__ __forceinline__ void phase_norm(const float* x, const float* g, const float* mod_sc, const float* mod_sh, bf16* xn, int vcu, int G, int tid) {
    const int lane = tid & 63, wave = __builtin_amdgcn_readfirstlane(tid >> 6);
    const int gw = vcu * NWAVES + wave, NGW = G * NWAVES;
    for (int m = gw; m < M; m += NGW) { const int b = m >> 12; norm_row_bf16(x + (size_t)m * D, g, mod_sc + (size_t)b * MODW, mod_sh + (size_t)b * MODW, xn + (size_t)m * D, lane); }
}

__device__ __forceinline__ void load_rot64(const bf16* src, int ld, const f32x2v* rope, float scale, bool useW, float log2g, LAS float* dst, int stride, int tid) {
    const int row = tid >> 2, i0 = (tid & 3) * 8;
    const v4u wa = *(const GAS v4u*)(src + (size_t)row * ld + i0), wb = *(const GAS v4u*)(src + (size_t)row * ld + i0 + 32);
    float t1[8], t2[8]; unpack8(wa, t1); unpack8(wb, t2);
    const float w = scale * (useW ? exp2f((float)(127 - row) * log2g) : 1.f);
#pragma unroll
    for (int j = 0; j < 8; ++j) { const f32x2v cs = rope[row * 32 + i0 + j];
        dst[row * stride + i0 + j] = (t1[j] * cs.x - t2[j] * cs.y) * w; dst[row * stride + i0 + 32 + j] = (t2[j] * cs.x + t1[j] * cs.y) * w; }
}
__device__ __forceinline__ float ret_log2g(int h) { return log2f(1.f - exp2f(-5.f - (float)h)); }
__device__ __forceinline__ void phase_ret_kv(const bf16* projA, const f32x2v* ropeR, float* KV, LAS unsigned char* lds, int vcu, int G, int tid) {
    LAS float* Ks = (LAS float*)lds; LAS float* Vs = (LAS float*)(lds + 32768);
    for (int u = vcu; u < 2048; u += G) {
        const int n = u & 31, h = (u >> 5) & 7, b = u >> 8; const int tok0 = b * SEQ + n * 128; const float l2g = ret_log2g(h);
        load_rot64(projA + (size_t)tok0 * NA + PA_RK + h * 64, NA, ropeR + (size_t)tok0 * 32, 0.125f, true, l2g, Ks, 64, tid);
        { const int row = tid >> 2, c0 = (tid & 3) * 32; const bf16* vp = projA + (size_t)(tok0 + row) * NA + PA_RV + h * 128 + c0;
#pragma unroll
          for (int q = 0; q < 4; ++q) { const v4u w = *(const GAS v4u*)(vp + q * 8); float f[8]; unpack8(w, f);
#pragma unroll
              for (int j = 0; j < 8; ++j) Vs[row * 128 + c0 + q * 8 + j] = f[j]; } }
        __syncthreads();
        const int e = tid & 127, dg = tid >> 7;
        float acc[16];
#pragma unroll
        for (int dd = 0; dd < 16; ++dd) acc[dd] = 0.f;
        for (int m = 0; m < 128; ++m) { const float vv = Vs[m * 128 + e];
#pragma unroll
            for (int dd = 0; dd < 16; ++dd) acc[dd] += Ks[m * 64 + dg * 16 + dd] * vv; }
#pragma unroll
        for (int dd = 0; dd < 16; ++dd) KV[((size_t)u * 64 + dg * 16 + dd) * 128 + e] = acc[dd];
        __syncthreads();
    }
}
__device__ __forceinline__ void phase_ret_scan(float* KV, int vcu, int G, int tid) {
    const size_t gt = (size_t)vcu * NTHR + tid, GT = (size_t)G * NTHR;
    for (size_t idx = gt; idx < (size_t)64 * 8192; idx += GT) { const int bh = (int)(idx >> 13), el = (int)(idx & 8191), h = bh & 7;
        const float cd = exp2f(128.f * ret_log2g(h)); float st = 0.f;
        for (int n = 0; n < 32; ++n) { float* p = KV + ((size_t)(bh * 32 + n) * 8192 + el); const float kv = *p; *p = st; st = st * cd + kv; } }
}
__device__ __forceinline__ void phase_ret_out(const bf16* projA, const f32x2v* ropeR, const float* KV, const float* gn_g, bf16* merged, LAS unsigned char* lds, int vcu, int G, int tid) {
    const int lane = tid & 63, wave = __builtin_amdgcn_readfirstlane(tid >> 6);
    LAS float* Qs = (LAS float*)lds; LAS float* Ks = (LAS float*)(lds + 32768); LAS float* Ss = (LAS float*)(lds + 66048);
    LAS unsigned short* Vs = (LAS unsigned short*)(lds + 32768);
    for (int u = vcu; u < 2048; u += G) {
        const int n = u & 31, h = (u >> 5) & 7, b = u >> 8; const int tok0 = b * SEQ + n * 128; const float l2g = ret_log2g(h);
        load_rot64(projA + (size_t)tok0 * NA + PA_RQ + h * 64, NA, ropeR + (size_t)tok0 * 32, 1.0f, false, 0.f, Qs, 64, tid);
        load_rot64(projA + (size_t)tok0 * NA + PA_RK + h * 64, NA, ropeR + (size_t)tok0 * 32, 0.125f, false, 0.f, Ks, 65, tid);
        __syncthreads();
        { const int m = tid & 127, cg = tid >> 7;
#pragma unroll 1
          for (int cc = 0; cc < 32; ++cc) { const int c = cg * 32 + cc; float s = 0.f;
              if (c >= m) {
#pragma unroll 4
                  for (int d = 0; d < 64; ++d) s += Qs[c * 64 + d] * Ks[m * 65 + d]; s *= exp2f((float)(c - m) * l2g); }
              Ss[c * 128 + m] = s; } }
        __syncthreads();
        { const int row = tid >> 2, c0 = (tid & 3) * 32; const bf16* vp = projA + (size_t)(tok0 + row) * NA + PA_RV + h * 128 + c0;
#pragma unroll
          for (int q = 0; q < 4; ++q) *(LAS v4u*)(Vs + row * 128 + c0 + q * 8) = *(const GAS v4u*)(vp + q * 8); }
        __syncthreads();
        const int e = tid & 127, cg = tid >> 7;
        float res[2][16];
#pragma unroll
        for (int hf_ = 0; hf_ < 2; ++hf_) {
            const int cb = cg * 32 + hf_ * 16;
            float acc[16];
#pragma unroll
            for (int cc = 0; cc < 16; ++cc) acc[cc] = 0.f;
#pragma unroll 1
            for (int d = 0; d < 64; ++d) { const float p = KV[((size_t)u * 64 + d) * 128 + e];
#pragma unroll
                for (int cc = 0; cc < 16; ++cc) acc[cc] += Qs[(cb + cc) * 64 + d] * p; }
#pragma unroll
            for (int cc = 0; cc < 16; ++cc) acc[cc] *= exp2f((float)(cb + cc + 1) * l2g);
#pragma unroll 1
            for (int m = 0; m < 128; ++m) { const float vv = bf2f(Vs[m * 128 + e]);
#pragma unroll
                for (int cc = 0; cc < 16; ++cc) acc[cc] += Ss[(cb + cc) * 128 + m] * vv; }
#pragma unroll
            for (int cc = 0; cc < 16; ++cc) res[hf_][cc] = acc[cc];
        }
        __syncthreads();
#pragma unroll
        for (int hf_ = 0; hf_ < 2; ++hf_)
#pragma unroll
            for (int cc = 0; cc < 16; ++cc) Ss[(cg * 32 + hf_ * 16 + cc) * 128 + e] = res[hf_][cc];
        __syncthreads();
#pragma unroll 1
        for (int r = 0; r < 16; ++r) { const int c = wave * 16 + r; const size_t tok = (size_t)tok0 + c;
            const float o0 = Ss[c * 128 + lane], o1 = Ss[c * 128 + 64 + lane];
            const float mu = wave_sum(o0 + o1) * (1.f / 128.f); const float d0 = o0 - mu, d1 = o1 - mu;
            const float var = wave_sum(d0 * d0 + d1 * d1) * (1.f / 128.f); const float rs = rsqrtf(var + EPS);
#pragma unroll
            for (int q = 0; q < 2; ++q) { const int ch = h * 128 + q * 64 + lane; const float dd = q ? d1 : d0;
                const float rg = bf2f(projA[tok * NA + PA_RG + ch]), ga = bf2f(projA[tok * NA + PA_GA + ch]);
                const float y = dd * rs * gn_g[ch] * siluf_(rg) * sigmoidf_(ga);
                bf16* mp = merged + tok * D + ch; *mp = (bf16)f2bf(bf2f(*mp) + y); } }
        __syncthreads();
    }
}

__device__ __forceinline__ void swa_load16(const bf16* src, const f32x2v* rope8, bool rot, float scale, float* f) {
    const v4u wa = *(const GAS v4u*)src, wb = *(const GAS v4u*)(src + 8);
    float t1[8], t2[8]; unpack8(wa, t1); unpack8(wb, t2);
#pragma unroll
    for (int j = 0; j < 8; ++j) { if (rot) { const f32x2v cs = rope8[j]; f[j] = (t1[j] * cs.x - t2[j] * cs.y) * scale; f[8 + j] = (t2[j] * cs.x + t1[j] * cs.y) * scale; } else { f[j] = t1[j] * scale; f[8 + j] = t2[j] * scale; } }
}
__device__ __forceinline__ void phase_swa(const bf16* projB, const f32x2v* ropeA, const float* sinks, bf16* merged, LAS unsigned char* lds, int vcu, int G, int tid) {
    const int lane = tid & 63, wave = __builtin_amdgcn_readfirstlane(tid >> 6);
    LAS float* Qs = (LAS float*)lds; LAS float* Ks = (LAS float*)(lds + 32768); LAS unsigned short* Vs = (LAS unsigned short*)(lds + 99328); LAS float* Ps = (LAS float*)(lds + 132096) + wave * 128;
    for (int u = vcu; u < 4096; u += G) {
        const int a = u & 15, n = (u >> 4) & 31, b = u >> 9, kvh = a >> 2; const int tok0 = b * SEQ + n * 128;
        { const int row = tid >> 2, seg = tid & 3; float f[16];
          swa_load16(projB + (size_t)(tok0 + row) * NB + PB_AQ + a * 64 + seg * 16, ropeA + (size_t)(tok0 + row) * 8, seg == 0, 0.125f, f);
#pragma unroll
          for (int j = 0; j < 16; ++j) Qs[row * 64 + seg * 16 + j] = f[j];
#pragma unroll
          for (int it = 0; it < 2; ++it) { const int kr = row + 128 * it; const int tok = tok0 - 128 + kr; const bool valid = (n > 0) || (kr >= 128);
              float kf[16]; v4u v0 = (v4u){0u, 0u, 0u, 0u}, v1 = v0;
              if (valid) { swa_load16(projB + (size_t)tok * NB + PB_AK + kvh * 64 + seg * 16, ropeA + (size_t)tok * 8, seg == 0, 1.0f, kf);
                  const bf16* vp = projB + (size_t)tok * NB + PB_AV + kvh * 64 + seg * 16; v0 = *(const GAS v4u*)vp; v1 = *(const GAS v4u*)(vp + 8); }
              else {
#pragma unroll
                  for (int j = 0; j < 16; ++j) kf[j] = 0.f; }
#pragma unroll
              for (int j = 0; j < 16; ++j) Ks[kr * 65 + seg * 16 + j] = kf[j];
              *(LAS v4u*)(Vs + kr * 64 + seg * 16) = v0; *(LAS v4u*)(Vs + kr * 64 + seg * 16 + 8) = v1; } }
        __syncthreads();
        const float sink = sinks[a];
        for (int r = 0; r < 16; ++r) { const int qi = wave * 16 + r; const int k0 = qi + 1 + lane, k1 = qi + 65 + lane;
            float s0 = 0.f, s1 = 0.f;
            for (int d = 0; d < 64; ++d) { const float q = Qs[qi * 64 + d]; s0 += q * Ks[k0 * 65 + d]; s1 += q * Ks[k1 * 65 + d]; }
            const bool v0 = (n * 128 - 128 + k0) >= 0, v1 = (n * 128 - 128 + k1) >= 0;
            if (!v0) s0 = -1e30f; if (!v1) s1 = -1e30f;
            const float mx = fmaxf(wave_max(fmaxf(s0, s1)), sink);
            const float p0 = v0 ? __expf(s0 - mx) : 0.f, p1 = v1 ? __expf(s1 - mx) : 0.f;
            const float den = wave_sum(p0 + p1) + __expf(sink - mx); const float inv = 1.f / den;
            Ps[lane] = p0 * inv; Ps[64 + lane] = p1 * inv;
            asm volatile("s_waitcnt lgkmcnt(0)" ::: "memory");
            float o = 0.f;
            for (int j = 0; j < 128; ++j) o += Ps[j] * bf2f(Vs[(qi + 1 + j) * 64 + lane]);
            asm volatile("s_waitcnt lgkmcnt(0)" ::: "memory");
            const size_t tok = (size_t)tok0 + qi; const float gb = bf2f(projB[tok * NB + PB_GB + a * 64 + lane]);
            merged[tok * D + a * 64 + lane] = (bf16)f2bf(o * sigmoidf_(gb)); }
        __syncthreads();
    }
}

__device__ __forceinline__ void phase_peer_topk(const bf16* qp, const bf16* k1b, const bf16* k2b, int* idxo, float* gateo, LAS unsigned char* lds, int vcu, int G, int tid) {
    const int lane = tid & 63, wave = __builtin_amdgcn_readfirstlane(tid >> 6);
    LAS unsigned short* K1s = (LAS unsigned short*)lds; LAS unsigned short* K2s = (LAS unsigned short*)(lds + 34816);
    LAS float* Qw = (LAS float*)(lds + 69632) + wave * 256; LAS float* Tv = (LAS float*)(lds + 77824) + wave * 64; LAS int* Ti = (LAS int*)(lds + 77824) + wave * 64 + 32;
    const float NEG = -3.0e38f;
    for (int u = vcu; u < 1024; u += G) {
        const int h = u & 7, tb = u >> 3;
#pragma unroll
        for (int i = 0; i < 4; ++i) { const int idx = tid + NTHR * i, row = idx >> 4, c8 = idx & 15;
            *(LAS v4u*)(K1s + row * 136 + c8 * 8) = *(const GAS v4u*)(k1b + ((size_t)h * 128 + row) * 128 + c8 * 8);
            *(LAS v4u*)(K2s + row * 136 + c8 * 8) = *(const GAS v4u*)(k2b + ((size_t)h * 128 + row) * 128 + c8 * 8); }
        __syncthreads();
        for (int i = 0; i < 32; ++i) { const size_t tok = (size_t)tb * 256 + wave * 32 + i;
            { const unsigned long long w = *(const GAS unsigned long long*)(qp + tok * NQP + h * 256 + 4 * lane);
              Qw[4 * lane + 0] = bflo((unsigned)w); Qw[4 * lane + 1] = bfhi((unsigned)w); Qw[4 * lane + 2] = bflo((unsigned)(w >> 32)); Qw[4 * lane + 3] = bfhi((unsigned)(w >> 32)); }
            asm volatile("s_waitcnt lgkmcnt(0)" ::: "memory");
            float s1a = 0.f, s1b = 0.f, s2a = 0.f, s2b = 0.f;
            for (int d8 = 0; d8 < 16; ++d8) { float q1[8], q2[8], f[8];
#pragma unroll
                for (int j = 0; j < 8; ++j) { q1[j] = Qw[d8 * 8 + j]; q2[j] = Qw[128 + d8 * 8 + j]; }
                unpack8(*(const LAS v4u*)(K1s + lane * 136 + d8 * 8), f);
#pragma unroll
                for (int j = 0; j < 8; ++j) s1a += q1[j] * f[j];
                unpack8(*(const LAS v4u*)(K1s + (lane + 64) * 136 + d8 * 8), f);
#pragma unroll
                for (int j = 0; j < 8; ++j) s1b += q1[j] * f[j];
                unpack8(*(const LAS v4u*)(K2s + lane * 136 + d8 * 8), f);
#pragma unroll
                for (int j = 0; j < 8; ++j) s2a += q2[j] * f[j];
                unpack8(*(const LAS v4u*)(K2s + (lane + 64) * 136 + d8 * 8), f);
#pragma unroll
                for (int j = 0; j < 8; ++j) s2b += q2[j] * f[j]; }
            float tv1 = NEG, tv2 = NEG; int ti1 = 0, ti2 = 0;
            for (int r = 0; r < 16; ++r) {
                float bv; int bi; if (s1a >= s1b) { bv = s1a; bi = lane; } else { bv = s1b; bi = lane + 64; }
                wave_argmax(bv, bi); if (lane == r) { tv1 = bv; ti1 = bi; } if (bi == lane) s1a = NEG; if (bi == lane + 64) s1b = NEG;
                if (s2a >= s2b) { bv = s2a; bi = lane; } else { bv = s2b; bi = lane + 64; }
                wave_argmax(bv, bi); if (lane == r) { tv2 = bv; ti2 = bi; } if (bi == lane) s2a = NEG; if (bi == lane + 64) s2b = NEG; }
            if (lane < 16) { Tv[lane] = tv1; Tv[16 + lane] = tv2; Ti[lane] = ti1; Ti[16 + lane] = ti2; }
            asm volatile("s_waitcnt lgkmcnt(0)" ::: "memory");
            float c0, c1, c2, c3;
            { const int aa = lane >> 2, b0 = (lane & 3) * 4; const float va = Tv[aa]; c0 = va + Tv[16 + b0]; c1 = va + Tv[16 + b0 + 1]; c2 = va + Tv[16 + b0 + 2]; c3 = va + Tv[16 + b0 + 3]; }
            float ts = NEG; int tp = 0;
            for (int r = 0; r < 16; ++r) {
                float bv = c0; int bi = lane * 4; if (c1 > bv) { bv = c1; bi = lane * 4 + 1; } if (c2 > bv) { bv = c2; bi = lane * 4 + 2; } if (c3 > bv) { bv = c3; bi = lane * 4 + 3; }
                wave_argmax(bv, bi); if (lane == r) { ts = bv; tp = bi; }
                if ((bi >> 2) == lane) { const int j = bi & 3; if (j == 0) c0 = NEG; else if (j == 1) c1 = NEG; else if (j == 2) c2 = NEG; else c3 = NEG; } }
            { float mx = ts;
#pragma unroll
              for (int o = 1; o < 16; o <<= 1) mx = fmaxf(mx, __shfl_xor(mx, o));
              const float ex = (lane < 16) ? expf(ts - mx) : 0.f; float sm = ex;
#pragma unroll
              for (int o = 1; o < 16; o <<= 1) sm += __shfl_xor(sm, o);
              if (lane < 16) { const int e = Ti[tp >> 4] * 128 + Ti[16 + (tp & 15)]; idxo[tok * 128 + h * 16 + lane] = e; gateo[tok * 128 + h * 16 + lane] = ex / sm; } }
            asm volatile("s_waitcnt lgkmcnt(0)" ::: "memory");
        }
        __syncthreads();
    }
}
__device__ __forceinline__ void phase_peer_gather(const bf16* xn2, const int* idx, const float* gate, const bf16* ub, const bf16* vb, float* x, const float* g2,
                                                  bool last, const float* ng, const float* nsc, const float* nsh, bf16* xn_next, int vcu, int G, int tid) {
    const int lane = tid & 63, wave = __builtin_amdgcn_readfirstlane(tid >> 6);
    const int gw = vcu * NWAVES + wave, NGW = G * NWAVES;
    for (int tok = gw; tok < M; tok += NGW) {
        const int b = tok >> 12;
        float hf[16];
        { const bf16* hr = xn2 + (size_t)tok * D; unpack8(*(const GAS v4u*)(hr + 8 * lane), hf); unpack8(*(const GAS v4u*)(hr + 512 + 8 * lane), hf + 8); }
        const int e_lo = idx[(size_t)tok * 128 + lane], e_hi = idx[(size_t)tok * 128 + 64 + lane];
        const float g_lo = gate[(size_t)tok * 128 + lane], g_hi = gate[(size_t)tok * 128 + 64 + lane];
        float y[16];
#pragma unroll
        for (int j = 0; j < 16; ++j) y[j] = 0.f;
#pragma unroll 2
        for (int k = 0; k < 128; ++k) {
            const int e = (k < 64) ? rl_i(e_lo, k & 63) : rl_i(e_hi, k & 63); const float gt = (k < 64) ? rl_f(g_lo, k & 63) : rl_f(g_hi, k & 63);
            const bf16* ur = ub + (size_t)e * D; const bf16* vr = vb + (size_t)e * D;
            float uf[16]; unpack8(*(const GAS v4u*)(ur + 8 * lane), uf); unpack8(*(const GAS v4u*)(ur + 512 + 8 * lane), uf + 8);
            float d = 0.f;
#pragma unroll
            for (int j = 0; j < 16; ++j) d += hf[j] * uf[j];
            d = wave_sum(d);
            const float act = 0.5f * d * (1.f + erff(d * 0.70710678118654752f)) * gt;
            float vf[16]; unpack8(*(const GAS v4u*)(vr + 8 * lane), vf); unpack8(*(const GAS v4u*)(vr + 512 + 8 * lane), vf + 8);
#pragma unroll
            for (int j = 0; j < 16; ++j) y[j] += act * vf[j];
        }
        float* xr = x + (size_t)tok * D; const float* gr = g2 + (size_t)b * MODW;
        float xv[16]; float ss = 0.f;
#pragma unroll
        for (int q = 0; q < 4; ++q) { const int c = (q >> 1) * 512 + 8 * lane + (q & 1) * 4; const f32x4 xa = *(const GAS f32x4*)(xr + c), ga = *(const GAS f32x4*)(gr + c);
#pragma unroll
            for (int j = 0; j < 4; ++j) { const float v = xa[j] + ga[j] * y[q * 4 + j]; xv[q * 4 + j] = v; ss += v * v; } }
        const float rstd = rsqrtf(wave_sum(ss) * (1.f / D) + EPS);
        if (last) {
#pragma unroll
            for (int q = 0; q < 4; ++q) { const int c = (q >> 1) * 512 + 8 * lane + (q & 1) * 4; const f32x4 gg = *(const GAS f32x4*)(ng + c);
                f32x4 o;
#pragma unroll
                for (int j = 0; j < 4; ++j) o[j] = xv[q * 4 + j] * rstd * gg[j];
                *(GAS f32x4*)(xr + c) = o; }
        } else {
            const float* scr_ = nsc + (size_t)b * MODW; const float* shr_ = nsh + (size_t)b * MODW; bf16* orow = xn_next + (size_t)tok * D;
#pragma unroll
            for (int q = 0; q < 4; ++q) { const int c = (q >> 1) * 512 + 8 * lane + (q & 1) * 4; const f32x4 gg = *(const GAS f32x4*)(ng + c), sc = *(const GAS f32x4*)(scr_ + c), sh = *(const GAS f32x4*)(shr_ + c);
                f32x4 xo; float hn[4];
#pragma unroll
                for (int j = 0; j < 4; ++j) { xo[j] = xv[q * 4 + j]; hn[j] = xv[q * 4 + j] * rstd * gg[j] * (1.f + sc[j]) + sh[j]; }
                *(GAS f32x4*)(xr + c) = xo;
                *(GAS unsigned long long*)(orow + c) = (unsigned long long)pk2(hn[0], hn[1]) | ((unsigned long long)pk2(hn[2], hn[3]) << 32); }
        }
    }
}

constexpr int PH_PER_LAYER = 11, N_PHASES = 2 + DEPTH * PH_PER_LAYER;
#ifndef PHASE_MASK
#define PHASE_MASK 0xFFFF
#endif
#define PM(k) ((PHASE_MASK >> (k)) & 1)
#ifndef MK_PER_PHASE
#define MK_PER_PHASE 0
#endif
__global__ void __launch_bounds__(NTHR, 2) mk_fwd(Args args) {
    extern __shared__ __attribute__((aligned(16))) unsigned char lds_raw[];
    LAS unsigned char* lds = (LAS unsigned char*)lds_raw;
    const int tid0 = threadIdx.x;
    const int G = gridDim.x; const int bx = blockIdx.x; const int vcu = (G % 8 == 0) ? (bx % 8) * (G / 8) + bx / 8 : bx;
    for (int u = tid0; u < (LDS_BYTES - LDSCTL_OFF) / 4; u += NTHR) ((LAS unsigned*)(lds + LDSCTL_OFF))[u] = 0u;
    __syncthreads();
    XcdBarrier bar; bar.bar = (unsigned*)(args.ws + WS_CTL) + CW_BAR; bar.x = 0; bar.st = nullptr;
    if (!MK_PER_PHASE) bar = xcd_barrier_post((unsigned*)(args.ws + WS_CTL) + CW_BAR, (volatile LAS unsigned*)(lds + LDSCTL_OFF) + 8);
    for (int p = args.ph_lo; p < args.ph_hi; ++p) {
        int tid = tid0; asm volatile("" : "+v"(tid));
        unsigned char* ws = args.ws; asm volatile("" : "+s"(ws));
        float* modp = (float*)(ws + WS_MOD);
        int l = 0, r = -1;
        if (p >= 2) { l = (p - 2) / PH_PER_LAYER; r = (p - 2) % PH_PER_LAYER; }
        const float* modl = modp + (size_t)l * 8 * MODW;
        if (p == 0) { if (PM(0)) phase_prologue(args, lds, vcu, G, tid); }
        else if (p == 1 || r == 7) {
            if (PM(1)) {
                const float* xs = (p == 1) ? args.in[0] : (const float*)args.out;
                const float* g = (p == 1) ? args.in[5] : args.in[6] + l * D;
                phase_norm(xs, g, modl + (p == 1 ? 1024 : 4096), modl + (p == 1 ? 0 : 3072), (bf16*)(ws + WS_XN), vcu, G, tid);
                if (p != 1) { const size_t gt = (size_t)vcu * NTHR + tid, GT = (size_t)G * NTHR;
                    cvt_f32_bf16(args.in[14] + (size_t)l * NEXP * D, (bf16*)(ws + WS_MERGED), (size_t)NEXP * D / 8, gt, GT);
                    cvt_f32_bf16(args.in[15] + (size_t)l * NEXP * D, (bf16*)(ws + WS_VB), (size_t)NEXP * D / 8, gt, GT); }
            }
        }
        else if (r == 0 || r == 2 || r == 8) {
            if (PM(2)) {
                const bf16* Bt; int N; bf16* O;
                if (r == 0) { Bt = (const bf16*)(ws + WS_WIN) + (size_t)l * NIN * D + (size_t)NA * D; N = NB; O = (bf16*)(ws + WS_PROJ); }
                else if (r == 2) { Bt = (const bf16*)(ws + WS_WIN) + (size_t)l * NIN * D; N = NA; O = (bf16*)(ws + WS_PROJ); }
                else { Bt = (const bf16*)(ws + WS_WQ) + (size_t)l * NQP * D; N = NQP; O = (bf16*)(ws + WS_QP); }
                pg8::Gemm g{(const bf16*)(ws + WS_XN), Bt, M, N, D}; pg8::StaticOrder S; S.init(M, N, G, bx);
                pg8::EpiBf16 E{O, N};
                pg8::gemm_phase<pg8::EpiBf16, pg8::StaticOrder, PG8_ALIGN, PG8_SP2>(lds, g, S, E);
            }
        }
        else if (r == 1) { if (PM(3)) phase_swa((const bf16*)(ws + WS_PROJ), (const f32x2v*)(ws + WS_ROPE_A), args.in[9] + l * 16, (bf16*)(ws + WS_MERGED), lds, vcu, G, tid); }
        else if (r == 3) { if (PM(4)) phase_ret_kv((const bf16*)(ws + WS_PROJ), (const f32x2v*)(ws + WS_ROPE_R), (float*)(ws + WS_XN), lds, vcu, G, tid); }
        else if (r == 4) { if (PM(5)) phase_ret_scan((float*)(ws + WS_XN), vcu, G, tid); }
        else if (r == 5) { if (PM(6)) phase_ret_out((const bf16*)(ws + WS_PROJ), (const f32x2v*)(ws + WS_ROPE_R), (const float*)(ws + WS_XN), args.in[8] + l * D, (bf16*)(ws + WS_MERGED), lds, vcu, G, tid); }
        else if (r == 6) {
            if (PM(7)) {
                pg8::Gemm g{(const bf16*)(ws + WS_MERGED), (const bf16*)(ws + WS_WOUT) + (size_t)l * D * D, M, D, D}; pg8::StaticOrder S; S.init(M, D, G, bx);
                pg8::EpiResGate E{l == 0 ? args.in[0] : (const float*)args.out, args.out, modl + 2048, MODW, D};
                pg8::gemm_phase<pg8::EpiResGate, pg8::StaticOrder, PG8_ALIGN, PG8_SP2>(lds, g, S, E);
            }
        }
        else if (r == 9) { if (PM(8)) phase_peer_topk((const bf16*)(ws + WS_QP), (const bf16*)(ws + WS_K1) + (size_t)l * 8 * 128 * 128, (const bf16*)(ws + WS_K2) + (size_t)l * 8 * 128 * 128, (int*)(ws + WS_IDX), (float*)(ws + WS_GATE), lds, vcu, G, tid); }
        else {
            if (PM(9)) {
                const bool last = (l == DEPTH - 1);
                const float* modn = modp + (size_t)(last ? l : l + 1) * 8 * MODW;
                phase_peer_gather((const bf16*)(ws + WS_XN), (const int*)(ws + WS_IDX), (const float*)(ws + WS_GATE), (const bf16*)(ws + WS_MERGED), (const bf16*)(ws + WS_VB), args.out, modl + 5120,
                                  last, last ? args.in[16] : args.in[5] + (l + 1) * D, modn + 1024, modn + 0, (bf16*)(ws + WS_XN), vcu, G, tid);
            }
        }
        if (!MK_PER_PHASE && p + 1 < args.ph_hi) xcd_barrier(bar);
    }
}

extern "C" void kernel_launch(void* const* d_in, const int* in_sizes, int n_in, void* d_out, int out_size, void* d_ws, size_t ws_size, hipStream_t stream) {
    static int grid = 0;
    if (grid == 0) {
        if (n_in != 17 || in_sizes[0] != M * D || out_size != M * D || ws_size < WS_END) { fprintf(stderr, "kernel_launch: unexpected problem (n_in %d, in0 %d, out %d, ws %zu < %zu); nothing launched\n", n_in, n_in > 0 ? in_sizes[0] : -1, out_size, ws_size, (size_t)WS_END); grid = -1; return; }
        int dev = 0, cus = 0, per_cu = 0;
        if (hipGetDevice(&dev) != hipSuccess || hipDeviceGetAttribute(&cus, hipDeviceAttributeMultiprocessorCount, dev) != hipSuccess) { grid = -1; return; }
        if (hipFuncSetAttribute((const void*)mk_fwd, hipFuncAttributeMaxDynamicSharedMemorySize, LDS_BYTES) != hipSuccess) { fprintf(stderr, "kernel_launch: hipFuncSetAttribute failed\n"); grid = -1; return; }
        if (hipOccupancyMaxActiveBlocksPerMultiprocessor(&per_cu, (const void*)mk_fwd, NTHR, LDS_BYTES) != hipSuccess || per_cu < 1) { fprintf(stderr, "kernel_launch: occupancy query says %d blocks per CU; nothing launched\n", per_cu); (void)hipGetLastError(); grid = -1; return; }
        (void)hipGetLastError();
        grid = cus;
    }
    if (grid < 0) return;
    if (hipMemsetAsync((char*)d_ws + WS_CTL, 0, CTL_ZERO_BYTES, stream) != hipSuccess) return;
    Args a{};
    for (int i = 0; i < 17; ++i) a.in[i] = (const float*)d_in[i];
    a.out = (float*)d_out; a.ws = (unsigned char*)d_ws;
#if MK_PER_PHASE
    for (int p = 0; p < N_PHASES; ++p) { a.ph_lo = p; a.ph_hi = p + 1; a.li = 0; hipLaunchKernelGGL(mk_fwd, dim3(grid), dim3(NTHR), LDS_BYTES, stream, a); }
#else
    a.ph_lo = 0; a.ph_hi = N_PHASES; a.li = 0;
    hipLaunchKernelGGL(mk_fwd, dim3(grid), dim3(NTHR), LDS_BYTES, stream, a);
#endif
}
```

```cpp
#include <hip/hip_runtime.h>
#include <cstdio>
#include <cstdint>
#include <cmath>
namespace pg8 {
#define PG8_LAS __attribute__((address_space(3)))
typedef unsigned short bf16_t;
typedef short bf16x8 __attribute__((ext_vector_type(8)));
typedef float f32x4 __attribute__((ext_vector_type(4)));
typedef unsigned u32x4 __attribute__((ext_vector_type(4)));
constexpr int BM = 256, BK = 64, HALF = 128, HTB = HALF * BK * 2  , STAGE_BYTES = 8 * HTB, NXCD = 8, WGM = 8;

__host__ __device__ __forceinline__ int lds_byte(int r, int c) { const int st = (r >> 4) * 2 + (c >> 5), rr = r & 15, cc = c & 31, ob = rr * 64 + cc * 2; return st * 1024 + (ob ^ (((ob >> 9) & 1) << 5)); }
__host__ __device__ __forceinline__ void stage_rc(int b, int& R, int& C) { const int st = b / 1024, sb = b % 1024, swz = sb ^ (((sb >> 9) & 1) << 5); R = (st >> 1) * 16 + swz / 64; C = (st & 1) * 32 + (swz % 64) / 2; }
__host__ __device__ __forceinline__ int perm32(int rho) { const int n = rho >> 4, i = rho & 15; return 8 * (i >> 2) + 4 * n + (i & 3); }

struct Unit { int pm, pn; };
struct Gemm { const bf16_t* A; const bf16_t* Bt; int M, N, K; };

struct StaticOrder {
    int nM, nN, nwg, G, c;
    __host__ __device__ void init(int M, int N, int G_, int c_) { nM = M / BM; nN = N / BM; nwg = nM * nN; G = G_; c = c_; }
    __host__ __device__ bool next(int i, Unit& u) const {
        const long L = (long)i * G + c; if (L >= nwg) return false;
        int wgid = (int)L; { const int q = nwg / NXCD, r = nwg % NXCD, xcd = wgid % NXCD, off = wgid / NXCD; wgid = (xcd < r ? xcd * (q + 1) : r * (q + 1) + (xcd - r) * q) + off; }
        const int nig = WGM * nN, gid = wgid / nig, fm = gid * WGM, gsz = (nM - fm) < WGM ? (nM - fm) : WGM;
        u.pm = fm + ((wgid % nig) % gsz); u.pn = (wgid % nig) / gsz; return true;
    }
    __device__ __forceinline__ void a_ready(const Unit&) const {}
    __device__ __forceinline__ void done(const Unit&) const {}
};

__device__ __forceinline__ unsigned cvt_pk_bf16(float lo, float hi) { unsigned r; asm volatile("v_cvt_pk_bf16_f32 %0, %1, %2" : "=v"(r) : "v"(lo), "v"(hi)); return r; }
typedef float f32x2 __attribute__((ext_vector_type(2)));
struct EpiBf16 {
    static constexpr bool PERM = true, AFTER_DRAIN = false;
    bf16_t* O; int ldc;
    __device__ __forceinline__ void operator()(const f32x4 (&acc)[2][2][4][2], const Unit& u, int wr, int wc, int fr, int fq) const {
        const int row0 = u.pm * BM + wr * 64 + fr; const int col0 = u.pn * BM + wc * 32 + 8 * fq;
#pragma unroll
        for (int ai = 0; ai < 2; ++ai)
#pragma unroll
            for (int m = 0; m < 4; ++m) { bf16_t* rowp = O + (size_t)(row0 + ai * HALF + m * 16) * ldc + col0;
#pragma unroll
                for (int bj = 0; bj < 2; ++bj) { const f32x4 v0 = acc[ai][bj][m][0], v1 = acc[ai][bj][m][1];
                    u32x4 w; w.x = cvt_pk_bf16(v0[0], v0[1]); w.y = cvt_pk_bf16(v0[2], v0[3]); w.z = cvt_pk_bf16(v1[0], v1[1]); w.w = cvt_pk_bf16(v1[2], v1[3]);
                    *(u32x4*)(rowp + bj * HALF) = w; } }
    }
};
struct EpiResGate {
    static constexpr bool PERM = false, AFTER_DRAIN = false;
    const float* xin; float* xout; const float* gate; int gate_ld; int ldc;
    __device__ __forceinline__ void operator()(const f32x4 (&acc)[2][2][4][2], const Unit& u, int wr, int wc, int fr, int fq) const {
        const int col0 = u.pn * BM + wc * 32 + 4 * fq; const int b = (u.pm * BM) >> 12;
        f32x4 gv[2][2];
#pragma unroll
        for (int bj = 0; bj < 2; ++bj)
#pragma unroll
            for (int n = 0; n < 2; ++n) gv[bj][n] = *(const f32x4*)(gate + (size_t)b * gate_ld + col0 + bj * HALF + n * 16);
#pragma unroll
        for (int ai = 0; ai < 2; ++ai)
#pragma unroll
            for (int m = 0; m < 4; ++m) { const size_t off = (size_t)(u.pm * BM + ai * HALF + wr * 64 + m * 16 + fr) * ldc + col0;
#pragma unroll
                for (int bj = 0; bj < 2; ++bj)
#pragma unroll
                    for (int n = 0; n < 2; ++n) { const f32x4 xi = *(const f32x4*)(xin + off + bj * HALF + n * 16); *(f32x4*)(xout + off + bj * HALF + n * 16) = xi + gv[bj][n] * acc[ai][bj][m][n]; } }
    }
};
struct EpiResGateB {
    static constexpr bool PERM = true, AFTER_DRAIN = false;
    const void* xin; int ldi; bool in_bf16; bf16_t* xout; int ldo; const float* gate; int gate_ld;
    __device__ __forceinline__ void operator()(const f32x4 (&acc)[2][2][4][2], const Unit& u, int wr, int wc, int fr, int fq) const {
        const int row0 = u.pm * BM + wr * 64 + fr; const int col0 = u.pn * BM + wc * 32 + 8 * fq; const int b = (u.pm * BM) >> 12;
        f32x4 gv[2][2];
#pragma unroll
        for (int bj = 0; bj < 2; ++bj)
#pragma unroll
            for (int n = 0; n < 2; ++n) gv[bj][n] = *(const f32x4*)(gate + (size_t)b * gate_ld + col0 + bj * HALF + n * 4);
        if (in_bf16) {
#pragma unroll
            for (int ai = 0; ai < 2; ++ai) {
                u32x4 w[4][2];
#pragma unroll
                for (int m = 0; m < 4; ++m)
#pragma unroll
                    for (int bj = 0; bj < 2; ++bj) w[m][bj] = *(const u32x4*)((const bf16_t*)xin + (size_t)(row0 + ai * HALF + m * 16) * ldi + col0 + bj * HALF);
                asm volatile("" ::: "memory");
#pragma unroll
                for (int m = 0; m < 4; ++m) { const size_t row = (size_t)(row0 + ai * HALF + m * 16);
#pragma unroll
                    for (int bj = 0; bj < 2; ++bj) { const u32x4 ww = w[m][bj];
                        const f32x4 x0 = {__builtin_bit_cast(float, ww.x << 16), __builtin_bit_cast(float, ww.x & 0xffff0000u), __builtin_bit_cast(float, ww.y << 16), __builtin_bit_cast(float, ww.y & 0xffff0000u)};
                        const f32x4 x1 = {__builtin_bit_cast(float, ww.z << 16), __builtin_bit_cast(float, ww.z & 0xffff0000u), __builtin_bit_cast(float, ww.w << 16), __builtin_bit_cast(float, ww.w & 0xffff0000u)};
                        const f32x4 v0 = x0 + gv[bj][0] * acc[ai][bj][m][0], v1 = x1 + gv[bj][1] * acc[ai][bj][m][1];
                        u32x4 o; o.x = cvt_pk_bf16(v0[0], v0[1]); o.y = cvt_pk_bf16(v0[2], v0[3]); o.z = cvt_pk_bf16(v1[0], v1[1]); o.w = cvt_pk_bf16(v1[2], v1[3]);
                        *(u32x4*)(xout + row * ldo + col0 + bj * HALF) = o; } }
            }
        } else {
#pragma unroll
            for (int ai = 0; ai < 2; ++ai)
#pragma unroll
                for (int mh = 0; mh < 2; ++mh) {
                    f32x4 xa[2][2][2];
#pragma unroll
                    for (int m2 = 0; m2 < 2; ++m2)
#pragma unroll
                        for (int bj = 0; bj < 2; ++bj) { const float* xp = (const float*)xin + (size_t)(row0 + ai * HALF + (2 * mh + m2) * 16) * ldi + col0 + bj * HALF; xa[m2][bj][0] = *(const f32x4*)xp; xa[m2][bj][1] = *(const f32x4*)(xp + 4); }
                    asm volatile("" ::: "memory");
#pragma unroll
                    for (int m2 = 0; m2 < 2; ++m2) { const int m = 2 * mh + m2; const size_t row = (size_t)(row0 + ai * HALF + m * 16);
#pragma unroll
                        for (int bj = 0; bj < 2; ++bj) {
                            const f32x4 v0 = xa[m2][bj][0] + gv[bj][0] * acc[ai][bj][m][0], v1 = xa[m2][bj][1] + gv[bj][1] * acc[ai][bj][m][1];
                            u32x4 o; o.x = cvt_pk_bf16(v0[0], v0[1]); o.y = cvt_pk_bf16(v0[2], v0[3]); o.z = cvt_pk_bf16(v1[0], v1[1]); o.w = cvt_pk_bf16(v1[2], v1[3]);
                            *(u32x4*)(xout + row * ldo + col0 + bj * HALF) = o; } }
                }
        }
    }
};
template <class Epi, class Sched, bool ALIGN_EPI = false, bool SP2 = false>
__device__ __forceinline__ void gemm_phase(PG8_LAS unsigned char* lds, const Gemm g, const Sched& S, const Epi& E) {
    int tid_ = threadIdx.x; asm volatile("" : "+v"(tid_));
    const int tid = tid_, wid = __builtin_amdgcn_readfirstlane(tid >> 6), lane = tid & 63, wr = wid >> 2, wc = wid & 3, fr = lane & 15, fq = lane >> 4;
    const int K = g.K, nt = K / BK;
    unsigned voffA[2], voffB[2];
#pragma unroll
    for (int i = 0; i < 2; ++i) { int R, C; stage_rc(tid * 16 + i * 8192, R, C); const int Rb = Epi::PERM ? ((R & ~31) + perm32(R & 31)) : R;
        voffA[i] = (unsigned)(R * K + C) * 2u; voffB[i] = (unsigned)(Rb * K + C) * 2u; }
    const size_t kstep = (size_t)(BK * 2);
    const size_t hstep = (size_t)HALF * K * 2;
    const size_t tstep = 2 * hstep;
    const unsigned ldsw = (unsigned)wid * 1024u;
    const int aoff = lds_byte(wr * 64 + fr, fq * 8), boff = lds_byte(wc * 32 + fr, fq * 8);
#define PG8_SA(b, h) (((b) * 2 + (h)) * HTB)
#define PG8_SB(b, h) ((4 + (b) * 2 + (h)) * HTB)
#define PG8_STAGE(bufoff, gbase, voff) do { _Pragma("unroll") for (int _i = 0; _i < 2; ++_i) \
        __builtin_amdgcn_global_load_lds((const unsigned*)((const char*)(gbase) + (voff)[_i]), (PG8_LAS unsigned*)(lds + (bufoff) + ldsw + _i * 8192), 16, 0, 0); } while (0)
#define PG8_LDA(dst, b, h) do { _Pragma("unroll") for (int m = 0; m < 4; ++m) _Pragma("unroll") for (int k = 0; k < 2; ++k) dst[m][k] = *(const PG8_LAS bf16x8*)(lds + PG8_SA(b, h) + aoff + m * 2048 + k * 1024); } while (0)
#define PG8_LDB(dst, b, h) do { _Pragma("unroll") for (int n = 0; n < 2; ++n) _Pragma("unroll") for (int k = 0; k < 2; ++k) dst[n][k] = *(const PG8_LAS bf16x8*)(lds + PG8_SB(b, h) + boff + n * 2048 + k * 1024); } while (0)
#define PG8_MMA(ai, bj, At, Bt) do { __builtin_amdgcn_s_setprio(1); _Pragma("unroll") for (int m = 0; m < 4; ++m) _Pragma("unroll") for (int n = 0; n < 2; ++n) _Pragma("unroll") for (int k = 0; k < 2; ++k) \
        acc[ai][bj][m][n] = __builtin_amdgcn_mfma_f32_16x16x32_bf16(Bt[n][k], At[m][k], acc[ai][bj][m][n], 0, 0, 0); __builtin_amdgcn_s_setprio(0); } while (0)
#define PG8_WAIT_V(n) asm volatile("s_waitcnt vmcnt(" #n ")" ::: "memory")
#define PG8_WAIT_L(n) asm volatile("s_waitcnt lgkmcnt(" #n ")" ::: "memory")
#define PG8_BAR __builtin_amdgcn_s_barrier()
#define PG8_SCHED __builtin_amdgcn_sched_barrier(0)
    Unit cur, nxt; int ui = 0;
    if (!S.next(0, cur)) return;
    f32x4 acc[2][2][4][2];
#pragma unroll
    for (int a = 0; a < 2; ++a)
#pragma unroll
        for (int b = 0; b < 2; ++b)
#pragma unroll
            for (int m = 0; m < 4; ++m)
#pragma unroll
                for (int n = 0; n < 2; ++n) acc[a][b][m][n] = (f32x4){0.f, 0.f, 0.f, 0.f};
    bf16x8 At[4][2], B0[2][2], B1[2][2];
    const char* cA = (const char*)g.A + (size_t)cur.pm * tstep; const char* cB = (const char*)g.Bt + (size_t)cur.pn * tstep;
    S.a_ready(cur);
    if constexpr (SP2) {
        PG8_STAGE(PG8_SB(0, 0), cB, voffB); PG8_STAGE(PG8_SB(0, 1), cB + hstep, voffB); PG8_STAGE(PG8_SA(0, 0), cA, voffA); PG8_STAGE(PG8_SA(0, 1), cA + hstep, voffA);
        if (wr == 1) PG8_BAR;
        PG8_WAIT_V(2); PG8_BAR;
        PG8_STAGE(PG8_SB(1, 0), cB + kstep, voffB); PG8_STAGE(PG8_SA(1, 0), cA + kstep, voffA); PG8_STAGE(PG8_SB(1, 1), cB + hstep + kstep, voffB);
        PG8_WAIT_V(6); PG8_BAR;
    } else {
        PG8_STAGE(PG8_SB(0, 0), cB, voffB); PG8_STAGE(PG8_SA(0, 0), cA, voffA); PG8_STAGE(PG8_SB(0, 1), cB + hstep, voffB); PG8_STAGE(PG8_SA(0, 1), cA + hstep, voffA);
        if (wr == 1) PG8_BAR;
        PG8_WAIT_V(4); PG8_BAR;
        PG8_STAGE(PG8_SB(1, 0), cB + kstep, voffB); PG8_STAGE(PG8_SA(1, 0), cA + kstep, voffA); PG8_STAGE(PG8_SB(1, 1), cB + hstep + kstep, voffB);
        PG8_WAIT_V(6); PG8_BAR;
    }
    for (;;) {
        const bool has_next = S.next(ui + 1, nxt);
        const char* nA = has_next ? (const char*)g.A + (size_t)nxt.pm * tstep : cA; const char* nB = has_next ? (const char*)g.Bt + (size_t)nxt.pn * tstep : cB;
        for (int t = 0; t < nt; t += 2) {
            const bool last = (t == nt - 2);
            const char* a1 = cA + (size_t)(t + 1) * kstep;
            const char* a2 = last ? nA : cA + (size_t)(t + 2) * kstep; const char* b2 = last ? nB : cB + (size_t)(t + 2) * kstep;
            const char* a3 = a2 + kstep; const char* b3 = b2 + kstep;
            if (last && has_next) S.a_ready(nxt);
            if constexpr (SP2) {
            PG8_LDB(B0, 0, 0); PG8_LDB(B1, 0, 1); PG8_SCHED; PG8_LDA(At, 0, 0); PG8_STAGE(PG8_SA(1, 1), a1 + hstep, voffA);
            PG8_WAIT_V(8); PG8_WAIT_L(0); PG8_BAR; PG8_MMA(0, 0, At, B0); PG8_MMA(0, 1, At, B1); PG8_BAR; PG8_SCHED;
            PG8_LDA(At, 0, 1); PG8_STAGE(PG8_SB(0, 0), b2, voffB); PG8_STAGE(PG8_SB(0, 1), b2 + hstep, voffB); PG8_STAGE(PG8_SA(0, 0), a2, voffA);
            PG8_WAIT_V(8); PG8_WAIT_L(0); PG8_BAR; PG8_MMA(1, 0, At, B0); PG8_MMA(1, 1, At, B1); PG8_BAR; PG8_SCHED;
            PG8_LDB(B0, 1, 0); PG8_LDB(B1, 1, 1); PG8_SCHED; PG8_LDA(At, 1, 0); PG8_STAGE(PG8_SA(0, 1), a2 + hstep, voffA);
            PG8_WAIT_V(8); PG8_WAIT_L(0); PG8_BAR; PG8_MMA(0, 0, At, B0); PG8_MMA(0, 1, At, B1); PG8_BAR; PG8_SCHED;
            PG8_LDA(At, 1, 1); PG8_STAGE(PG8_SB(1, 0), b3, voffB); PG8_STAGE(PG8_SB(1, 1), b3 + hstep, voffB); PG8_STAGE(PG8_SA(1, 0), a3, voffA);
            PG8_WAIT_V(8); PG8_WAIT_L(0); PG8_BAR; PG8_MMA(1, 0, At, B0); PG8_MMA(1, 1, At, B1); PG8_BAR; PG8_SCHED;
            } else {
            PG8_LDB(B0, 0, 0); PG8_SCHED; PG8_LDA(At, 0, 0); PG8_STAGE(PG8_SA(1, 1), a1 + hstep, voffA);
            PG8_WAIT_L(8); PG8_BAR; PG8_WAIT_L(0); PG8_MMA(0, 0, At, B0); PG8_BAR; PG8_SCHED;
            PG8_LDB(B1, 0, 1); PG8_STAGE(PG8_SB(0, 0), b2, voffB);
            PG8_BAR; PG8_WAIT_L(0); PG8_MMA(0, 1, At, B1); PG8_BAR;
            PG8_LDA(At, 0, 1); PG8_STAGE(PG8_SA(0, 0), a2, voffA);
            PG8_BAR; PG8_WAIT_L(0); PG8_MMA(1, 0, At, B0); PG8_BAR; PG8_SCHED;
            PG8_STAGE(PG8_SB(0, 1), b2 + hstep, voffB);
            PG8_WAIT_V(6); PG8_BAR; PG8_MMA(1, 1, At, B1); PG8_BAR;
            PG8_LDB(B0, 1, 0); PG8_SCHED; PG8_LDA(At, 1, 0); PG8_STAGE(PG8_SA(0, 1), a2 + hstep, voffA);
            PG8_WAIT_L(8); PG8_BAR; PG8_WAIT_L(0); PG8_MMA(0, 0, At, B0); PG8_BAR; PG8_SCHED;
            PG8_LDB(B1, 1, 1); PG8_STAGE(PG8_SB(1, 0), b3, voffB);
            PG8_BAR; PG8_WAIT_L(0); PG8_MMA(0, 1, At, B1); PG8_BAR;
            PG8_LDA(At, 1, 1); PG8_STAGE(PG8_SA(1, 0), a3, voffA);
            PG8_BAR; PG8_WAIT_L(0); PG8_MMA(1, 0, At, B0); PG8_BAR; PG8_SCHED;
            PG8_STAGE(PG8_SB(1, 1), b3 + hstep, voffB);
            PG8_WAIT_V(6); PG8_BAR; PG8_MMA(1, 1, At, B1); PG8_BAR;
            }
        }
        if constexpr (ALIGN_EPI) { if (wr == 0) PG8_BAR; }
        if constexpr (!Epi::AFTER_DRAIN) { E(acc, cur, wr, wc, fr, fq); S.done(cur); }
        if (!has_next) break;
#pragma unroll
        for (int a = 0; a < 2; ++a)
#pragma unroll
            for (int b = 0; b < 2; ++b)
#pragma unroll
                for (int m = 0; m < 4; ++m)
#pragma unroll
                    for (int n = 0; n < 2; ++n) acc[a][b][m][n] = (f32x4){0.f, 0.f, 0.f, 0.f};
        cur = nxt; cA = nA; cB = nB; ++ui;
        if constexpr (ALIGN_EPI) { if (wr == 1) PG8_BAR; }
    }
    PG8_WAIT_V(0);
    if constexpr (!ALIGN_EPI) { if (wr == 0) PG8_BAR; }
    PG8_BAR;
    if constexpr (Epi::AFTER_DRAIN) { E.fused(acc, cur, wr, wc, fr, fq, lds, wid, lane); S.done(cur); }
#undef PG8_SA
#undef PG8_SB
#undef PG8_STAGE
#undef PG8_LDA
#undef PG8_LDB
#undef PG8_MMA
#undef PG8_WAIT_V
#undef PG8_WAIT_L
#undef PG8_BAR
#undef PG8_SCHED
}
}
#define PG8_SP2 true
#define PG8_ALIGN true
#define GAS __attribute__((address_space(1)))
#define LAS __attribute__((address_space(3)))
typedef unsigned short bf16;
typedef unsigned v4u __attribute__((ext_vector_type(4)));
typedef float f32x4 __attribute__((ext_vector_type(4)));
typedef short bf16x8 __attribute__((ext_vector_type(8)));
typedef GAS unsigned gu32;
typedef GAS unsigned long long gu64;
#define RLX_AGENT __ATOMIC_RELAXED, __HIP_MEMORY_SCOPE_AGENT
#define LDS_WAIT() asm volatile("s_waitcnt lgkmcnt(0)" ::: "memory")
#define VM_WAIT() asm volatile("s_waitcnt vmcnt(0)" ::: "memory")
__device__ __forceinline__ unsigned long long rt() { return __builtin_amdgcn_s_memrealtime(); }
__device__ __forceinline__ unsigned f2bf(float f) { unsigned u = __builtin_bit_cast(unsigned, f); return (u + 0x7fffu + ((u >> 16) & 1u)) >> 16; }
typedef float f32x2p_ __attribute__((ext_vector_type(2)));
typedef __bf16 bf16x2p_ __attribute__((ext_vector_type(2)));
__device__ __forceinline__ unsigned pk2(float lo, float hi) { f32x2p_ v = {lo, hi}; bf16x2p_ b = __builtin_convertvector(v, bf16x2p_); return __builtin_bit_cast(unsigned, b); }
#define XB_TMO      128
#define XB_XCNT(j)  (256  + 64 * (j))
#define XB_XSUB(j)  (1280 + 64 * (j))
#define XB_XGEN(j)  (2304 + 64 * (j))
#define XB_TOP      3328
#define XB_TOPGEN   3392
#define XCD_BAR_WORDS 3456
#define XB_SPIN_CAP (1u << 18)

__device__ __forceinline__ unsigned xb_ld(unsigned* p)              { return __hip_atomic_load(p, __ATOMIC_RELAXED, __HIP_MEMORY_SCOPE_AGENT); }
__device__ __forceinline__ unsigned xb_add(unsigned* p, unsigned v) { return __hip_atomic_fetch_add(p, v, __ATOMIC_RELAXED, __HIP_MEMORY_SCOPE_AGENT); }
__device__ __forceinline__ unsigned xb_xcc_id() { return (unsigned)__builtin_amdgcn_s_getreg((3 << 11) | 20) & 0xFu; }
#define XB_SPIN(cond, bar) do { unsigned _sp = 0; while (cond) { __builtin_amdgcn_s_sleep(1); \
    if ((++_sp & 255u) == 0u) { if (xb_ld(&(bar)[XB_TMO])) break; if (_sp > XB_SPIN_CAP) { atomicAdd(&(bar)[XB_TMO], 1u); break; } } } } while (0)

struct XcdBarrier {
    unsigned* bar; unsigned x;
    volatile LAS unsigned* st;
};

__device__ __forceinline__ XcdBarrier xcd_barrier_post(unsigned* bar, volatile LAS unsigned* st) {
    XcdBarrier b; b.bar = bar; b.x = xb_xcc_id(); b.st = st;
    if (threadIdx.x == 0) (void)xb_add(&bar[XB_XCNT(b.x)], 1u);
    return b;
}
__device__ __forceinline__ void xcd_barrier_complete(unsigned* bar, unsigned x, unsigned& nloc, unsigned& nx) {
    const unsigned G = gridDim.x * gridDim.y * gridDim.z;
    unsigned sum, cnt, mine, sp = 0u;
    for (;;) {
        sum = 0u; cnt = 0u; mine = 0u;
#pragma unroll
        for (unsigned j = 0; j < 16; ++j) { const unsigned c = xb_ld(&bar[XB_XCNT(j)]); sum += c; cnt += (c > 0u) ? 1u : 0u; mine = (j == x) ? c : mine; }
        if (sum == G) break;
        __builtin_amdgcn_s_sleep(1);
        if ((++sp & 255u) == 0u) { if (xb_ld(&bar[XB_TMO])) break; if (sp > XB_SPIN_CAP) { atomicAdd(&bar[XB_TMO], 1u); break; } }
    }
    nloc = mine > 0u ? mine : 1u; nx = cnt > 0u ? cnt : 1u;
}

__device__ __forceinline__ void xcd_barrier(const XcdBarrier& b) {
    asm volatile("s_waitcnt vmcnt(0)" ::: "memory");
    __syncthreads();
    if (threadIdx.x == 0) {
        unsigned* bar = b.bar;
        __builtin_amdgcn_s_waitcnt(0);
        unsigned nloc = b.st[0], nx = b.st[1];
        if (nloc == 0u) { xcd_barrier_complete(bar, b.x, nloc, nx); b.st[0] = nloc; b.st[1] = nx; }
        const unsigned old = xb_add(&bar[XB_XSUB(b.x)], 1u);
        const unsigned gen = old / nloc;
        if (old + 1u == (gen + 1u) * nloc) {
            __builtin_amdgcn_fence(__ATOMIC_RELEASE, "agent");
            asm volatile("s_waitcnt vmcnt(0)" ::: "memory");
            const unsigned og = xb_add(&bar[XB_TOP], 1u);
            const unsigned tg = og / nx;
            if (og + 1u == (tg + 1u) * nx) xb_add(&bar[XB_TOPGEN], 1u);
            else XB_SPIN(xb_ld(&bar[XB_TOPGEN]) == tg, bar);
            __builtin_amdgcn_fence(__ATOMIC_ACQUIRE, "agent");
            xb_add(&bar[XB_XGEN(b.x)], 1u);
            asm volatile("s_waitcnt vmcnt(0)" ::: "memory");
        } else {
            XB_SPIN(xb_ld(&bar[XB_XGEN(b.x)]) == gen, bar);
            __builtin_amdgcn_fence(__ATOMIC_ACQUIRE, "agent");
            asm volatile("s_waitcnt vmcnt(0)" ::: "memory");
        }
    }
    __syncthreads();
}
constexpr int NWAVES = 8, NTHR = 512;
constexpr int BATCH = 8, SEQ = 4096, D = 1024, M = BATCH * SEQ, DEPTH = 2;
constexpr int NIN = 6656, NA = 4096, NB = 2560;
constexpr int PA_RQ = 0, PA_RK = 512, PA_RV = 1024, PA_RG = 2048, PA_GA = 3072;
constexpr int PB_AQ = 0, PB_AK = 1024, PB_AV = 1280, PB_GB = 1536;
constexpr int NQP = 2048, NEXP = 16384, MODW = 6144;
constexpr float EPS = 1e-6f;
constexpr int XP = 2048;
constexpr size_t MiB = 1u << 20;
constexpr size_t WS_CTL = 0, CTL_ZERO_BYTES = 1 * MiB;
constexpr size_t WS_MOD = 1 * MiB;
constexpr size_t WS_ROPE_R = 2 * MiB;
constexpr size_t WS_ROPE_A = 10 * MiB;
constexpr size_t WS_WIN = 12 * MiB;
constexpr size_t WS_WOUT = 38 * MiB;
constexpr size_t WS_WQ = 42 * MiB;
constexpr size_t WS_K1 = 50 * MiB;
constexpr size_t WS_K2 = WS_K1 + 512 * 1024;
constexpr size_t WS_XN = 52 * MiB;
constexpr size_t WS_MERGED = 116 * MiB;
constexpr size_t WS_PROJ = 180 * MiB;
constexpr size_t WS_QP = WS_PROJ, WS_IDX = WS_PROJ + 128 * MiB, WS_GATE = WS_PROJ + 144 * MiB;
constexpr size_t WS_U8 = WS_MERGED, WS_V8 = WS_MERGED + 16 * MiB, WS_SU = WS_MERGED + 32 * MiB, WS_SV = WS_MERGED + 33 * MiB;
constexpr size_t WS_PREVT = 436 * MiB;
constexpr size_t WS_END = 468 * MiB;
constexpr int CW_BAR = 4096;
constexpr int SCR_BYTES = 147456;
constexpr int LDSCTL_OFF = SCR_BYTES, LDS_BYTES = SCR_BYTES + 1024;

typedef float f32x2v __attribute__((ext_vector_type(2)));
struct Args { const float* in[17]; float* out; unsigned char* ws; int ph_lo, ph_hi, li, pad; };
__device__ const float INV_R[32] = {1.000000000e+00f, 7.498942614e-01f, 5.623413324e-01f, 4.216965139e-01f, 3.162277639e-01f, 2.371373773e-01f, 1.778279394e-01f, 1.333521307e-01f, 1.000000015e-01f, 7.498941571e-02f, 5.623413250e-02f, 4.216965288e-02f, 3.162277490e-02f, 2.371373773e-02f, 1.778279431e-02f, 1.333521493e-02f, 9.999999776e-03f, 7.498941850e-03f, 5.623413250e-03f, 4.216964822e-03f, 3.162277630e-03f, 2.371373586e-03f, 1.778279431e-03f, 1.333521446e-03f, 1.000000047e-03f, 7.498942432e-04f, 5.623413017e-04f, 4.216965172e-04f, 3.162277571e-04f, 2.371373703e-04f, 1.778279402e-04f, 1.333521504e-04f};
__device__ const float INV_A[8] = {1.000000000e+00f, 1.939227432e-01f, 3.760603070e-02f, 7.292664610e-03f, 1.414213562e-03f, 2.742481884e-04f, 5.318296098e-05f, 1.031338616e-05f};

__device__ __forceinline__ float bflo(unsigned w) { return __builtin_bit_cast(float, w << 16); }
__device__ __forceinline__ float bfhi(unsigned w) { return __builtin_bit_cast(float, w & 0xffff0000u); }
__device__ __forceinline__ float bf2f(unsigned short h) { return __builtin_bit_cast(float, (unsigned)h << 16); }
__device__ __forceinline__ void unpack8(const v4u w, float* f) { f[0] = bflo(w.x); f[1] = bfhi(w.x); f[2] = bflo(w.y); f[3] = bfhi(w.y); f[4] = bflo(w.z); f[5] = bfhi(w.z); f[6] = bflo(w.w); f[7] = bfhi(w.w); }
typedef unsigned v2u_ __attribute__((ext_vector_type(2)));
template <int CTRL> __device__ __forceinline__ float dpp_f(float v) { return __builtin_bit_cast(float, __builtin_amdgcn_update_dpp(0, __builtin_bit_cast(int, v), CTRL, 0xf, 0xf, true)); }
__device__ __forceinline__ void swap16_(float v, float& a, float& b) { const v2u_ s = __builtin_amdgcn_permlane16_swap(__builtin_bit_cast(unsigned, v), __builtin_bit_cast(unsigned, v), false, false); const unsigned a_ = s.x, b_ = s.y; a = __builtin_bit_cast(float, a_); b = __builtin_bit_cast(float, b_); }
__device__ __forceinline__ void swap32_(float v, float& a, float& b) { const v2u_ s = __builtin_amdgcn_permlane32_swap(__builtin_bit_cast(unsigned, v), __builtin_bit_cast(unsigned, v), false, false); const unsigned a_ = s.x, b_ = s.y; a = __builtin_bit_cast(float, a_); b = __builtin_bit_cast(float, b_); }
__device__ __forceinline__ float wave_sum(float v) {
    v += dpp_f<0xB1>(v); v += dpp_f<0x4E>(v); v += dpp_f<0x141>(v); v += dpp_f<0x140>(v);
    float a, b; swap16_(v, a, b); v = a + b; swap32_(v, a, b); return a + b;
}
__device__ __forceinline__ float wave_max(float v) {
    v = fmaxf(v, dpp_f<0xB1>(v)); v = fmaxf(v, dpp_f<0x4E>(v)); v = fmaxf(v, dpp_f<0x141>(v)); v = fmaxf(v, dpp_f<0x140>(v));
    float a, b; swap16_(v, a, b); v = fmaxf(a, b); swap32_(v, a, b); return fmaxf(a, b);
}
#define LDS_BARRIER() do { asm volatile("s_waitcnt lgkmcnt(0)" ::: "memory"); __builtin_amdgcn_s_barrier(); asm volatile("" ::: "memory"); } while (0)
__device__ __forceinline__ float sigmoidf_(float x) { return __builtin_amdgcn_rcpf(1.f + __expf(-x)); }
__device__ __forceinline__ float siluf_(float x) { return x * __builtin_amdgcn_rcpf(1.f + __expf(-x)); }
__device__ __forceinline__ float rl_f(float v, int k) { return __builtin_bit_cast(float, __builtin_amdgcn_readlane(__builtin_bit_cast(int, v), k)); }
__device__ __forceinline__ int rl_i(int v, int k) { return __builtin_amdgcn_readlane(v, k); }

__device__ __forceinline__ void p0_transpose_item(const float* W, int K, int N, bf16* WT, int mode, LAS float* scr, int item, int lane) {
    const int nblk = N / 32, kb = item / nblk, nb = item % nblk, k0 = 64 * kb, n0 = 32 * nb;
    int d0 = n0;
    if (mode == 1) { if (n0 >= 3072 && n0 < 4608) d0 = n0 + 1024; else if (n0 >= 4608 && n0 < 5632) d0 = n0 - 1536; }
#pragma unroll 8
    for (int i = 0; i < 32; ++i) { const int kk = 2 * i + (lane >> 5); scr[kk * 33 + (lane & 31)] = W[(size_t)(k0 + kk) * N + n0 + (lane & 31)]; }
    LDS_WAIT(); asm volatile("" ::: "memory");
    const int c = lane & 7;
#pragma unroll
    for (int j = 0; j < 4; ++j) { const int n = (lane >> 3) + 8 * j; const LAS float* s = scr + (8 * c) * 33 + n;
        v4u o; o.x = pk2(s[0 * 33], s[1 * 33]); o.y = pk2(s[2 * 33], s[3 * 33]); o.z = pk2(s[4 * 33], s[5 * 33]); o.w = pk2(s[6 * 33], s[7 * 33]);
        *(GAS v4u*)(WT + (size_t)(d0 + n) * K + k0 + 8 * c) = o; }
    LDS_WAIT(); asm volatile("" ::: "memory");
}
__device__ __forceinline__ void cvt_f32_bf16(const float* src, bf16* dst, size_t n8, size_t g0, size_t gstride) {
    for (size_t i = g0; i < n8; i += gstride) { const f32x4 a = *(const GAS f32x4*)(src + i * 8), b = *(const GAS f32x4*)(src + i * 8 + 4);
        v4u o; o.x = pk2(a.x, a.y); o.y = pk2(a.z, a.w); o.z = pk2(b.x, b.y); o.w = pk2(b.z, b.w); *(GAS v4u*)(dst + i * 8) = o; }
}
__device__ __forceinline__ void phase_prologue(const Args& a, LAS unsigned char* lds, int vcu, int G, int tid) {
    const int lane = tid & 63, wave = __builtin_amdgcn_readfirstlane(tid >> 6);
    unsigned char* ws = a.ws;
    if (vcu < 192) {
        LAS float* cond = (LAS float*)lds; LAS float* red = (LAS float*)(lds + 32768);
        const float* c = a.in[1];
        for (int i = tid; i < BATCH * D; i += NTHR) { const float v = c[i]; cond[i] = v / (1.f + expf(-v)); }
        __syncthreads();
        const int l = vcu / 96, j0 = (vcu % 96) * 64, col = tid & 63, ks = tid >> 6;
        const float* W = a.in[3] + (size_t)l * D * MODW + j0 + col;
        float acc[8];
#pragma unroll
        for (int b = 0; b < 8; ++b) acc[b] = 0.f;
        for (int k = ks * 128; k < ks * 128 + 128; ++k) { const float w = W[(size_t)k * MODW];
#pragma unroll
            for (int b = 0; b < 8; ++b) acc[b] += cond[b * D + k] * w; }
#pragma unroll
        for (int b = 0; b < 8; ++b) red[(ks * 8 + b) * 64 + col] = acc[b];
        __syncthreads();
        { const int b = tid >> 6; float s = 0.f;
#pragma unroll
          for (int k2 = 0; k2 < 8; ++k2) s += red[(k2 * 8 + b) * 64 + col];
          s += a.in[4][l * MODW + j0 + col];
          ((float*)(ws + WS_MOD))[(size_t)(l * 8 + b) * MODW + j0 + col] = s; }
        __syncthreads();
    }
    {
        LAS float* scr = (LAS float*)(lds + 49152 + wave * 8448);
        const int gw = vcu * NWAVES + wave, NGW = G * NWAVES;
        constexpr int I_IN = (D / 64) * (NIN / 32), I_OUT = (D / 64) * (D / 32), I_Q = (D / 64) * (NQP / 32), I_L = I_IN + I_OUT + I_Q;
        for (int it = gw; it < 2 * I_L; it += NGW) {
            const int l = it / I_L; int r = it % I_L;
            if (r < I_IN) { p0_transpose_item(a.in[7] + (size_t)l * D * NIN, D, NIN, (bf16*)(ws + WS_WIN) + (size_t)l * NIN * D, 1, scr, r, lane); continue; } r -= I_IN;
            if (r < I_OUT) { p0_transpose_item(a.in[10] + (size_t)l * D * D, D, D, (bf16*)(ws + WS_WOUT) + (size_t)l * D * D, 0, scr, r, lane); continue; } r -= I_OUT;
            p0_transpose_item(a.in[11] + (size_t)l * D * NQP, D, NQP, (bf16*)(ws + WS_WQ) + (size_t)l * NQP * D, 0, scr, r, lane);
        }
    }
    const size_t gt = (size_t)vcu * NTHR + tid, GT = (size_t)G * NTHR;
    cvt_f32_bf16(a.in[12], (bf16*)(ws + WS_K1), (size_t)2 * 8 * 128 * 128 / 8, gt, GT);
    cvt_f32_bf16(a.in[13], (bf16*)(ws + WS_K2), (size_t)2 * 8 * 128 * 128 / 8, gt, GT);
    {
        const int* pos = (const int*)a.in[2];
        unsigned* tr = (unsigned*)(ws + WS_ROPE_R); unsigned* ta = (unsigned*)(ws + WS_ROPE_A);
        for (size_t idx = gt; idx < (size_t)M * 32; idx += GT) { const int m = (int)(idx >> 5), i = (int)(idx & 31);
            const float ang = (float)pos[m] * INV_R[i]; const double t = (double)ang * 0.15915494309189535; const float r = (float)(t - rint(t));
            tr[idx] = pk2(__builtin_amdgcn_cosf(r), __builtin_amdgcn_sinf(r)); }
        for (size_t idx = gt; idx < (size_t)M * 8; idx += GT) { const int m = (int)(idx >> 3), i = (int)(idx & 7);
            const float ang = (float)pos[m] * INV_A[i]; const double t = (double)ang * 0.15915494309189535; const float r = (float)(t - rint(t));
            ta[idx] = pk2(__builtin_amdgcn_cosf(r), __builtin_amdgcn_sinf(r)); }
    }
}

__device__ __forceinline__ void phase_norm(const float* x, const float* g, const float* mod_sc, const float* mod_sh, bf16* xn, int vcu, int G, int tid) {
    const int lane = tid & 63, wave = __builtin_amdgcn_readfirstlane(tid >> 6);
    const int gw = vcu * NWAVES + wave, NGW = G * NWAVES;
    constexpr int RI = 4;
    f32x4 gg[4];
#pragma unroll
    for (int j = 0; j < 4; ++j) gg[j] = ((const GAS f32x4*)g)[lane + 64 * j];
    for (int m0 = gw * RI; m0 < M; m0 += NGW * RI) {
        f32x4 v[RI][4]; float s[RI];
#pragma unroll
        for (int r = 0; r < RI; ++r) { const int m = m0 + r; const GAS f32x4* xr = (const GAS f32x4*)(x + (size_t)(m < M ? m : gw) * D) + lane;
#pragma unroll
            for (int j = 0; j < 4; ++j) v[r][j] = xr[64 * j]; }
#pragma unroll
        for (int r = 0; r < RI; ++r) { float a = 0.f;
#pragma unroll
            for (int j = 0; j < 4; ++j) a += (v[r][j].x * v[r][j].x + v[r][j].y * v[r][j].y) + (v[r][j].z * v[r][j].z + v[r][j].w * v[r][j].w);
            s[r] = a; }
#pragma unroll
        for (int r = 0; r < RI; ++r) s[r] = wave_sum(s[r]);
#pragma unroll
        for (int r = 0; r < RI; ++r) { const int m = m0 + r; const int mc = m < M ? m : gw; const int b = mc >> 12; const float rstd = rsqrtf(s[r] * (1.f / D) + EPS);
            const float* sc = mod_sc + (size_t)b * MODW; const float* sh = mod_sh + (size_t)b * MODW;
            f32x4 cc[4], hh[4];
#pragma unroll
            for (int j = 0; j < 4; ++j) { cc[j] = ((const GAS f32x4*)sc)[lane + 64 * j]; hh[j] = ((const GAS f32x4*)sh)[lane + 64 * j]; }
            asm volatile("" ::: "memory");
            if (m < M) { GAS unsigned long long* o8 = (GAS unsigned long long*)(xn + (size_t)m * D) + lane;
#pragma unroll
                for (int j = 0; j < 4; ++j) { const f32x4 y = (v[r][j] * rstd * gg[j]) * (cc[j] + 1.0f) + hh[j];
                    o8[64 * j] = (unsigned long long)pk2(y.x, y.y) | ((unsigned long long)pk2(y.z, y.w) << 32); } } }
    }
}
__device__ __forceinline__ void phase_norm_b(const bf16* x, const float* g, const float* mod_sc, const float* mod_sh, bf16* xn, int vcu, int G, int tid) {
    const int lane = tid & 63, wave = __builtin_amdgcn_readfirstlane(tid >> 6);
    const int gw = vcu * NWAVES + wave, NGW = G * NWAVES;
    constexpr int RI = 4;
    f32x4 gg[2][2];
#pragma unroll
    for (int j = 0; j < 2; ++j)
#pragma unroll
        for (int q = 0; q < 2; ++q) gg[j][q] = *(const GAS f32x4*)(g + 8 * (lane + 64 * j) + 4 * q);
    for (int m0 = gw * RI; m0 < M; m0 += NGW * RI) {
        v4u v[RI][2]; float s[RI];
#pragma unroll
        for (int r = 0; r < RI; ++r) { const int m = m0 + r; const GAS v4u* xr = (const GAS v4u*)(x + (size_t)(m < M ? m : gw) * XP) + lane; v[r][0] = xr[0]; v[r][1] = xr[64]; }
#pragma unroll
        for (int r = 0; r < RI; ++r) { float f[16]; unpack8(v[r][0], f); unpack8(v[r][1], f + 8); float a = 0.f;
#pragma unroll
            for (int j = 0; j < 16; j += 4) a += (f[j] * f[j] + f[j + 1] * f[j + 1]) + (f[j + 2] * f[j + 2] + f[j + 3] * f[j + 3]);
            s[r] = a; }
#pragma unroll
        for (int r = 0; r < RI; ++r) s[r] = wave_sum(s[r]);
#pragma unroll
        for (int r = 0; r < RI; ++r) { const int m = m0 + r; const int mc = m < M ? m : gw; const int b = mc >> 12; const float rstd = rsqrtf(s[r] * (1.f / D) + EPS);
            const float* sc = mod_sc + (size_t)b * MODW; const float* sh = mod_sh + (size_t)b * MODW;
            f32x4 cc[2][2], hh[2][2];
#pragma unroll
            for (int j = 0; j < 2; ++j)
#pragma unroll
                for (int q = 0; q < 2; ++q) { cc[j][q] = *(const GAS f32x4*)(sc + 8 * (lane + 64 * j) + 4 * q); hh[j][q] = *(const GAS f32x4*)(sh + 8 * (lane + 64 * j) + 4 * q); }
            asm volatile("" ::: "memory");
            if (m < M) {
#pragma unroll
                for (int j = 0; j < 2; ++j) { const int c0 = 8 * (lane + 64 * j); float f[8]; unpack8(v[r][j], f); unsigned pk[4];
#pragma unroll
                    for (int q = 0; q < 2; ++q) { const f32x4 xv = (f32x4){f[4 * q], f[4 * q + 1], f[4 * q + 2], f[4 * q + 3]};
                        const f32x4 y = (xv * rstd * gg[j][q]) * (cc[j][q] + 1.0f) + hh[j][q]; pk[2 * q] = pk2(y.x, y.y); pk[2 * q + 1] = pk2(y.z, y.w); }
                    *(GAS v4u*)(xn + (size_t)m * D + c0) = (v4u){pk[0], pk[1], pk[2], pk[3]}; } } }
    }
}

__device__ __forceinline__ float ret_log2g(int h) { return log2f(1.f - exp2f(-5.f - (float)h)); }
typedef float f32x16v_ __attribute__((ext_vector_type(16)));
typedef short bf16x8v_ __attribute__((ext_vector_type(8)));
typedef __bf16 bf16x2_t_ __attribute__((ext_vector_type(2)));
__device__ __forceinline__ unsigned cvtpk_(float lo, float hi) { f32x2v v = {lo, hi}; bf16x2_t_ b = __builtin_convertvector(v, bf16x2_t_); return __builtin_bit_cast(unsigned, b); }
__device__ __forceinline__ int mrow(int r, int h5) { return (r & 3) + 8 * (r >> 2) + 4 * h5; }
__device__ __forceinline__ void phase_swa_mfma(const bf16* projB, const unsigned* ropeA, const float* sinks, bf16* merged, LAS unsigned char* lds, int vcu, int G, int tid) {
    const int lane = tid & 63, wave = __builtin_amdgcn_readfirstlane(tid >> 6), h5 = lane >> 5, l31 = lane & 31;
    LAS unsigned short* Ks = (LAS unsigned short*)lds;
    LAS unsigned short* Vt = (LAS unsigned short*)(lds + 36864);
    const float L2E = 1.4426950408889634f;
    const int frow = tid >> 1, fhalf = tid & 1;
    v4u kw[4], vw[4], kcs[2];
#define SWA_LOAD(uu) do { const int kvh_ = (uu) & 3, n_ = ((uu) >> 2) & 31, b_ = (uu) >> 7; int tok_ = b_ * SEQ + n_ * 128 - 128 + frow; tok_ = (n_ > 0 || frow >= 128) ? tok_ : b_ * SEQ + frow; \
        const bf16* kp_ = projB + (size_t)tok_ * NB + PB_AK + kvh_ * 64 + fhalf * 32; const bf16* vp_ = projB + (size_t)tok_ * NB + PB_AV + kvh_ * 64 + fhalf * 32; \
        _Pragma("unroll") for (int i = 0; i < 4; ++i) { kw[i] = *(const GAS v4u*)(kp_ + 8 * i); vw[i] = *(const GAS v4u*)(vp_ + 8 * i); } \
        kcs[0] = *(const GAS v4u*)(ropeA + (size_t)tok_ * 8); kcs[1] = *(const GAS v4u*)(ropeA + (size_t)tok_ * 8 + 4); } while (0)
    if (vcu < 1024) SWA_LOAD(vcu);
    for (int u = vcu; u < 1024; u += G) {
        const int kvh = u & 3, n = (u >> 2) & 31, b = u >> 7; const int tok0 = b * SEQ + n * 128;
        const int a = kvh * 4 + (wave >> 1);
        v4u qraw[2][4]; v4u qcs[2][2];
#pragma unroll
        for (int i = 0; i < 2; ++i) { const size_t token = (size_t)tok0 + (wave & 1) * 64 + 32 * i + l31; const bf16* qp = projB + token * NB + PB_AQ + a * 64 + 8 * h5;
#pragma unroll
            for (int s_ = 0; s_ < 4; ++s_) qraw[i][s_] = *(const GAS v4u*)(qp + 16 * s_);
            qcs[i][0] = *(const GAS v4u*)(ropeA + token * 8); qcs[i][1] = *(const GAS v4u*)(ropeA + token * 8 + 4); }
        {
            const int row = frow, half = fhalf; const bool valid = (n > 0) || (row >= 128);
            if (half == 0) { float t1[8], t2[8]; unpack8(kw[0], t1); unpack8(kw[1], t2); float o1[8], o2[8];
#pragma unroll
                for (int j = 0; j < 8; ++j) { const unsigned cw_ = kcs[j >> 2][j & 3]; const float cc = bflo(cw_), ss = bfhi(cw_); o1[j] = t1[j] * cc - t2[j] * ss; o2[j] = t2[j] * cc + t1[j] * ss; }
                kw[0] = (v4u){cvtpk_(o1[0], o1[1]), cvtpk_(o1[2], o1[3]), cvtpk_(o1[4], o1[5]), cvtpk_(o1[6], o1[7])};
                kw[1] = (v4u){cvtpk_(o2[0], o2[1]), cvtpk_(o2[2], o2[3]), cvtpk_(o2[4], o2[5]), cvtpk_(o2[6], o2[7])}; }
            const unsigned vm_ = valid ? 0xffffffffu : 0u;
#pragma unroll
            for (int i = 0; i < 4; ++i) *(LAS v4u*)(Ks + row * 72 + half * 32 + 8 * i) = (v4u){kw[i].x & vm_, kw[i].y & vm_, kw[i].z & vm_, kw[i].w & vm_};
#pragma unroll
            for (int i = 0; i < 4; ++i)
#pragma unroll
                for (int j = 0; j < 4; ++j) { const unsigned w = vw[i][j] & vm_; Vt[(half * 32 + 8 * i + 2 * j) * 260 + row] = (unsigned short)(w & 0xffffu); Vt[(half * 32 + 8 * i + 2 * j + 1) * 260 + row] = (unsigned short)(w >> 16); }
        }
        LDS_BARRIER();
        if (u + G < 1024) SWA_LOAD(u + G);
        const float sink = sinks[a];
#pragma unroll
        for (int i = 0; i < 2; ++i) {
            const int q0 = (wave & 1) * 64 + 32 * i, kt0 = q0 >> 5; const size_t token = (size_t)tok0 + q0 + l31;
            bf16x8v_ qf[4];
            { v4u qw[4];
#pragma unroll
              for (int s_ = 0; s_ < 4; ++s_) qw[s_] = qraw[i][s_];
              v4u pw;
#pragma unroll
              for (int j = 0; j < 4; ++j) pw[j] = (unsigned)__shfl_xor((int)qw[0][j], 32);
              float own[8], oth[8]; unpack8(qw[0], own); unpack8(pw, oth); float o[8];
#pragma unroll
              for (int j = 0; j < 8; ++j) { const unsigned cw_ = qcs[i][j >> 2][j & 3]; const f32x2v c = (f32x2v){bflo(cw_), bfhi(cw_)}; const float ow_ = own[j], ot_ = oth[j]; const float t1 = h5 ? ot_ : ow_, t2 = h5 ? ow_ : ot_; o[j] = (h5 ? (t2 * c.x + t1 * c.y) : (t1 * c.x - t2 * c.y)) * 0.125f; }
              qw[0] = (v4u){cvtpk_(o[0], o[1]), cvtpk_(o[2], o[3]), cvtpk_(o[4], o[5]), cvtpk_(o[6], o[7])};
#pragma unroll
              for (int s_ = 1; s_ < 4; ++s_) { float f[8]; unpack8(qw[s_], f); qw[s_] = (v4u){cvtpk_(f[0] * 0.125f, f[1] * 0.125f), cvtpk_(f[2] * 0.125f, f[3] * 0.125f), cvtpk_(f[4] * 0.125f, f[5] * 0.125f), cvtpk_(f[6] * 0.125f, f[7] * 0.125f)}; }
#pragma unroll
              for (int s_ = 0; s_ < 4; ++s_) qf[s_] = __builtin_bit_cast(bf16x8v_, qw[s_]); }
            f32x16v_ sacc[5];
#pragma unroll
            for (int jt = 0; jt < 5; ++jt) {
#pragma unroll
                for (int r = 0; r < 16; ++r) sacc[jt][r] = 0.f;
#pragma unroll
                for (int s_ = 0; s_ < 4; ++s_) { const bf16x8v_ kf = *(const LAS bf16x8v_*)(Ks + (32 * (kt0 + jt) + l31) * 72 + 16 * s_ + 8 * h5); sacc[jt] = __builtin_amdgcn_mfma_f32_32x32x16_bf16(kf, qf[s_], sacc[jt], 0, 0, 0); }
            }
            v4u gwv[4];
#pragma unroll
            for (int i2 = 0; i2 < 4; ++i2) gwv[i2] = *(const GAS v4u*)(projB + token * NB + PB_GB + a * 64 + 32 * h5 + 8 * i2);
            float mx = -1e30f;
#pragma unroll
            for (int jt = 0; jt < 5; ++jt) { const bool tile_ok = (n > 0) || (kt0 + jt >= 4);
#pragma unroll
                for (int r = 0; r < 16; ++r) { const int kl = mrow(r, h5); bool ok = tile_ok; if (jt == 0) ok = ok && (kl > l31); if (jt == 4) ok = ok && (kl <= l31);
                    const float sv_ = ok ? sacc[jt][r] : -1e30f; sacc[jt][r] = sv_; mx = fmaxf(mx, sv_); } }
            mx = fmaxf(mx, __shfl_xor(mx, 32)); mx = fmaxf(mx, sink);
            float sm = 0.f; const float mxl = -mx * L2E;
#pragma unroll
            for (int jt = 0; jt < 5; ++jt)
#pragma unroll
                for (int r = 0; r < 16; ++r) { const float p = __builtin_amdgcn_exp2f(fmaf(sacc[jt][r], L2E, mxl)); sacc[jt][r] = p; sm += p; }
            sm += __shfl_xor(sm, 32);
            const float inv = __builtin_amdgcn_rcpf(sm + __builtin_amdgcn_exp2f(fmaf(sink, L2E, mxl)));
            f32x16v_ oacc[2];
#pragma unroll
            for (int dt = 0; dt < 2; ++dt)
#pragma unroll
                for (int r = 0; r < 16; ++r) oacc[dt][r] = 0.f;
#pragma unroll
            for (int jt = 0; jt < 5; ++jt)
#pragma unroll
                for (int s2 = 0; s2 < 2; ++s2) {
                    const v4u pw = (v4u){cvtpk_(sacc[jt][8 * s2 + 0], sacc[jt][8 * s2 + 1]), cvtpk_(sacc[jt][8 * s2 + 2], sacc[jt][8 * s2 + 3]), cvtpk_(sacc[jt][8 * s2 + 4], sacc[jt][8 * s2 + 5]), cvtpk_(sacc[jt][8 * s2 + 6], sacc[jt][8 * s2 + 7])};
                    const bf16x8v_ pf = __builtin_bit_cast(bf16x8v_, pw);
#pragma unroll
                    for (int dt = 0; dt < 2; ++dt) { const LAS unsigned short* vp_ = Vt + (32 * dt + l31) * 260 + 32 * (kt0 + jt) + 16 * s2 + 4 * h5;
                        const unsigned long long lo = *(const LAS unsigned long long*)vp_, hi = *(const LAS unsigned long long*)(vp_ + 8);
                        const v4u aw = (v4u){(unsigned)lo, (unsigned)(lo >> 32), (unsigned)hi, (unsigned)(hi >> 32)};
                        oacc[dt] = __builtin_amdgcn_mfma_f32_32x32x16_bf16(__builtin_bit_cast(bf16x8v_, aw), pf, oacc[dt], 0, 0, 0); }
                }
            { LAS float* Ow = (LAS float*)(lds + 70144) + wave * (32 * 68);
#pragma unroll
              for (int dt = 0; dt < 2; ++dt)
#pragma unroll
                  for (int g_ = 0; g_ < 4; ++g_) *(LAS f32x4*)(Ow + l31 * 68 + 32 * dt + 8 * g_ + 4 * h5) = (f32x4){oacc[dt][4 * g_ + 0] * inv, oacc[dt][4 * g_ + 1] * inv, oacc[dt][4 * g_ + 2] * inv, oacc[dt][4 * g_ + 3] * inv};
              asm volatile("s_waitcnt lgkmcnt(0)" ::: "memory");
              bf16* mp = merged + token * D + a * 64 + 32 * h5;
#pragma unroll
              for (int i2 = 0; i2 < 4; ++i2) { const f32x4 oa = *(const LAS f32x4*)(Ow + l31 * 68 + 32 * h5 + 8 * i2), ob = *(const LAS f32x4*)(Ow + l31 * 68 + 32 * h5 + 8 * i2 + 4);
                  float gf[8]; unpack8(gwv[i2], gf);
                  *(GAS v4u*)(mp + 8 * i2) = (v4u){cvtpk_(oa[0] * sigmoidf_(gf[0]), oa[1] * sigmoidf_(gf[1])), cvtpk_(oa[2] * sigmoidf_(gf[2]), oa[3] * sigmoidf_(gf[3])),
                                                   cvtpk_(ob[0] * sigmoidf_(gf[4]), ob[1] * sigmoidf_(gf[5])), cvtpk_(ob[2] * sigmoidf_(gf[6]), ob[3] * sigmoidf_(gf[7]))}; }
              asm volatile("s_waitcnt lgkmcnt(0)" ::: "memory"); }
        }
        LDS_BARRIER();
    }
#undef SWA_LOAD
}


typedef short v4i16_ __attribute__((ext_vector_type(4)));
__device__ __forceinline__ v4i16_ lds_tr4(const LAS unsigned short* p) { return __builtin_amdgcn_ds_read_tr16_b64_v4i16((LAS v4i16_*)p); }
__device__ __forceinline__ void phase_ret_kv_mfma(const bf16* projA, const unsigned* ropeR, float* KVT, LAS unsigned char* lds, int vcu, int G, int tid) {
    const int lane = tid & 63, wave = __builtin_amdgcn_readfirstlane(tid >> 6), h5 = lane >> 5, l31 = lane & 31;
    LAS unsigned short* Kr = (LAS unsigned short*)lds;
    LAS unsigned short* Vr = (LAS unsigned short*)(lds + 24576);
    const int m = tid >> 2, seg = tid & 3, i0 = seg * 8;
    v4u wa, wb, vw[4], cs[2];
#define R1_LOAD(uu) do { const int n_ = (uu) & 31, h_ = ((uu) >> 5) & 7, b_ = (uu) >> 8; const size_t tok_ = (size_t)b_ * SEQ + n_ * 128 + m; \
        const bf16* kp_ = projA + tok_ * NA + PA_RK + h_ * 64; wa = *(const GAS v4u*)(kp_ + i0); wb = *(const GAS v4u*)(kp_ + i0 + 32); \
        cs[0] = *(const GAS v4u*)(ropeR + tok_ * 32 + i0); cs[1] = *(const GAS v4u*)(ropeR + tok_ * 32 + i0 + 4); \
        const bf16* vp_ = projA + tok_ * NA + PA_RV + h_ * 128 + seg * 32; _Pragma("unroll") for (int i = 0; i < 4; ++i) vw[i] = *(const GAS v4u*)(vp_ + 8 * i); } while (0)
    if (vcu < 2048) R1_LOAD(vcu);
    const int trq = (lane & 15) >> 2, trp = lane & 3, trg = (lane >> 4) & 1;
    for (int u = vcu; u < 2048; u += G) {
        const int h = (u >> 5) & 7; const float l2g = ret_log2g(h);
        { float t1[8], t2[8]; unpack8(wa, t1); unpack8(wb, t2); const float w = 0.125f * __builtin_amdgcn_exp2f((float)(127 - m) * l2g); float o1[8], o2[8];
#pragma unroll
          for (int j = 0; j < 8; ++j) { const unsigned cw_ = cs[j >> 2][j & 3]; const f32x2v c = (f32x2v){bflo(cw_), bfhi(cw_)}; o1[j] = (t1[j] * c.x - t2[j] * c.y) * w; o2[j] = (t2[j] * c.x + t1[j] * c.y) * w; }
          *(LAS v4u*)(Kr + m * 96 + i0) = (v4u){cvtpk_(o1[0], o1[1]), cvtpk_(o1[2], o1[3]), cvtpk_(o1[4], o1[5]), cvtpk_(o1[6], o1[7])};
          *(LAS v4u*)(Kr + m * 96 + i0 + 32) = (v4u){cvtpk_(o2[0], o2[1]), cvtpk_(o2[2], o2[3]), cvtpk_(o2[4], o2[5]), cvtpk_(o2[6], o2[7])};
#pragma unroll
          for (int i = 0; i < 4; ++i) *(LAS v4u*)(Vr + m * 160 + seg * 32 + 8 * i) = vw[i]; }
        LDS_BARRIER();
        if (u + G < 2048) R1_LOAD(u + G);
        const int dvt = wave >> 1, dkt = wave & 1;
        f32x16v_ acc;
#pragma unroll
        for (int r = 0; r < 16; ++r) acc[r] = 0.f;
        const LAS unsigned short* va = Vr + (8 * h5 + trq) * 160 + 32 * dvt + 16 * trg + 4 * trp;
        const LAS unsigned short* ka = Kr + (8 * h5 + trq) * 96 + 32 * dkt + 16 * trg + 4 * trp;
#pragma unroll
        for (int s_ = 0; s_ < 8; ++s_) { const v4i16_ a0 = lds_tr4(va + 16 * s_ * 160), a1 = lds_tr4(va + (16 * s_ + 4) * 160), b0 = lds_tr4(ka + 16 * s_ * 96), b1 = lds_tr4(ka + (16 * s_ + 4) * 96);
            const bf16x8v_ af = (bf16x8v_){a0[0], a0[1], a0[2], a0[3], a1[0], a1[1], a1[2], a1[3]}, bfr = (bf16x8v_){b0[0], b0[1], b0[2], b0[3], b1[0], b1[1], b1[2], b1[3]};
            acc = __builtin_amdgcn_mfma_f32_32x32x16_bf16(af, bfr, acc, 0, 0, 0); }
        bf16* op = (bf16*)KVT + (size_t)u * 8192 + 32 * dkt + l31;
#pragma unroll
        for (int r = 0; r < 16; ++r) { const float v_ = acc[r]; const float nb_ = dpp_f<0xB1>(v_); if ((lane & 1) == 0) *(GAS unsigned*)(op + (size_t)(32 * dvt + mrow(r, h5)) * 64) = pk2(v_, nb_); }
        LDS_BARRIER();
    }
#undef R1_LOAD
}
__device__ __forceinline__ void phase_ret_scan2(const float* KVT, bf16* PREVT, int vcu, int G, int tid) {
    const size_t gt = (size_t)vcu * NTHR + tid, GT_ = (size_t)G * NTHR;
    const unsigned* KVb = (const unsigned*)KVT;
    for (size_t idx = gt; idx < (size_t)64 * 4096; idx += GT_) { const int bh = (int)(idx >> 12), pr = (int)(idx & 4095), h = bh & 7;
        const float cd = exp2f(128.f * ret_log2g(h)); f32x2v st = (f32x2v){0.f, 0.f}; unsigned kv[32];
#pragma unroll
        for (int n = 0; n < 32; ++n) kv[n] = KVb[(size_t)(bh * 32 + n) * 4096 + pr];
#pragma unroll
        for (int n = 0; n < 32; ++n) { *(GAS unsigned*)(PREVT + (size_t)(bh * 32 + n) * 8192 + 2 * pr) = pk2(st.x, st.y); st = st * cd + (f32x2v){bflo(kv[n]), bfhi(kv[n])}; } }
}
__device__ __forceinline__ void phase_ret_out_mfma(const bf16* projA, const unsigned* ropeR, const bf16* PREVT, const float* gn_g, bf16* merged, LAS unsigned char* lds, int vcu, int G, int tid) {
    const int lane = tid & 63, wave = __builtin_amdgcn_readfirstlane(tid >> 6), h5 = lane >> 5, l31 = lane & 31;
    LAS unsigned short* Ks = (LAS unsigned short*)lds;
    LAS unsigned short* Vt = (LAS unsigned short*)(lds + 18432);
    LAS unsigned short* St = (LAS unsigned short*)(lds + 52224);
    LAS float* Xs = (LAS float*)(lds + 70656);
    const int m = tid >> 2, seg = tid & 3, i0 = seg * 8;
    v4u wa, wb, vw[4], pvw[2], fcs[2];
#define R3_LOAD(uu) do { const int n_ = (uu) & 31, h_ = ((uu) >> 5) & 7, b_ = (uu) >> 8; const size_t tok_ = (size_t)b_ * SEQ + n_ * 128 + m; \
        const bf16* kp_ = projA + tok_ * NA + PA_RK + h_ * 64; wa = *(const GAS v4u*)(kp_ + i0); wb = *(const GAS v4u*)(kp_ + i0 + 32); \
        fcs[0] = *(const GAS v4u*)(ropeR + tok_ * 32 + i0); fcs[1] = *(const GAS v4u*)(ropeR + tok_ * 32 + i0 + 4); \
        const bf16* vp_ = projA + tok_ * NA + PA_RV + h_ * 128 + seg * 32; _Pragma("unroll") for (int i = 0; i < 4; ++i) vw[i] = *(const GAS v4u*)(vp_ + 8 * i); \
        _Pragma("unroll") for (int i = 0; i < 2; ++i) { const int idx_ = tid + NTHR * i; pvw[i] = *(const GAS v4u*)(PREVT + (size_t)(uu) * 8192 + (idx_ >> 3) * 64 + 8 * (idx_ & 7)); } } while (0)
    if (vcu < 2048) R3_LOAD(vcu);
    for (int u = vcu; u < 2048; u += G) {
        const int n = u & 31, h = (u >> 5) & 7, b = u >> 8; const int tok0 = b * SEQ + n * 128; const float l2g = ret_log2g(h);
        const int ct = wave & 3, dvh = wave >> 2; const size_t token = (size_t)tok0 + 32 * ct + l31;
        v4u qraw[4]; v4u qcs[2][2];
        { const bf16* qp = projA + token * NA + PA_RQ + h * 64 + 8 * h5;
#pragma unroll
          for (int s_ = 0; s_ < 4; ++s_) qraw[s_] = *(const GAS v4u*)(qp + 16 * s_);
#pragma unroll
          for (int s_ = 0; s_ < 2; ++s_) { qcs[s_][0] = *(const GAS v4u*)(ropeR + token * 32 + 16 * s_ + 8 * h5); qcs[s_][1] = *(const GAS v4u*)(ropeR + token * 32 + 16 * s_ + 8 * h5 + 4); } }
        { float t1[8], t2[8]; unpack8(wa, t1); unpack8(wb, t2); float o1[8], o2[8];
#pragma unroll
          for (int j = 0; j < 8; ++j) { const unsigned cw_ = fcs[j >> 2][j & 3]; const f32x2v c = (f32x2v){bflo(cw_), bfhi(cw_)}; o1[j] = (t1[j] * c.x - t2[j] * c.y) * 0.125f; o2[j] = (t2[j] * c.x + t1[j] * c.y) * 0.125f; }
          *(LAS v4u*)(Ks + m * 72 + i0) = (v4u){cvtpk_(o1[0], o1[1]), cvtpk_(o1[2], o1[3]), cvtpk_(o1[4], o1[5]), cvtpk_(o1[6], o1[7])};
          *(LAS v4u*)(Ks + m * 72 + i0 + 32) = (v4u){cvtpk_(o2[0], o2[1]), cvtpk_(o2[2], o2[3]), cvtpk_(o2[4], o2[5]), cvtpk_(o2[6], o2[7])};
#pragma unroll
          for (int i = 0; i < 4; ++i)
#pragma unroll
              for (int j = 0; j < 4; ++j) { const unsigned wv_ = vw[i][j]; Vt[(seg * 32 + 8 * i + 2 * j) * 132 + m] = (unsigned short)(wv_ & 0xffffu); Vt[(seg * 32 + 8 * i + 2 * j + 1) * 132 + m] = (unsigned short)(wv_ >> 16); }
#pragma unroll
          for (int i = 0; i < 2; ++i) { const int idx = tid + NTHR * i, row = idx >> 3, c8 = idx & 7; *(LAS v4u*)(St + row * 72 + 8 * c8) = pvw[i]; } }
        LDS_BARRIER();
        if (u + G < 2048) R3_LOAD(u + G);
        bf16x8v_ qf[4];
        {
#pragma unroll
          for (int s_ = 0; s_ < 2; ++s_) { float t1[8], t2[8]; unpack8(qraw[s_], t1); unpack8(qraw[s_ + 2], t2); float o1[8], o2[8];
#pragma unroll
              for (int j = 0; j < 8; ++j) { const unsigned cw_ = qcs[s_][j >> 2][j & 3]; const f32x2v c = (f32x2v){bflo(cw_), bfhi(cw_)}; o1[j] = t1[j] * c.x - t2[j] * c.y; o2[j] = t2[j] * c.x + t1[j] * c.y; }
              qf[s_] = __builtin_bit_cast(bf16x8v_, (v4u){cvtpk_(o1[0], o1[1]), cvtpk_(o1[2], o1[3]), cvtpk_(o1[4], o1[5]), cvtpk_(o1[6], o1[7])});
              qf[s_ + 2] = __builtin_bit_cast(bf16x8v_, (v4u){cvtpk_(o2[0], o2[1]), cvtpk_(o2[2], o2[3]), cvtpk_(o2[4], o2[5]), cvtpk_(o2[6], o2[7])}); } }
        float fa[4], fb[4];
#pragma unroll
        for (int i = 0; i < 4; ++i) { fa[i] = __builtin_amdgcn_exp2f(-(float)(i + 4 * h5) * l2g); fb[i] = __builtin_amdgcn_exp2f(-(float)(8 * i) * l2g); }
        const float Ec = __builtin_amdgcn_exp2f((float)l31 * l2g);
        f32x16v_ oacc[2];
#pragma unroll
        for (int dvt = 0; dvt < 2; ++dvt)
#pragma unroll
            for (int r = 0; r < 16; ++r) oacc[dvt][r] = 0.f;
#pragma unroll 1
        for (int mt = 0; mt <= ct; ++mt) {
            f32x16v_ sacc;
#pragma unroll
            for (int r = 0; r < 16; ++r) sacc[r] = 0.f;
#pragma unroll
            for (int s_ = 0; s_ < 4; ++s_) { const bf16x8v_ kf = *(const LAS bf16x8v_*)(Ks + (32 * mt + l31) * 72 + 16 * s_ + 8 * h5); sacc = __builtin_amdgcn_mfma_f32_32x32x16_bf16(kf, qf[s_], sacc, 0, 0, 0); }
            const float TE = __builtin_amdgcn_exp2f((float)(32 * (ct - mt)) * l2g) * Ec; const bool diag = (mt == ct);
#pragma unroll
            for (int r = 0; r < 16; ++r) { float v = sacc[r] * (TE * fb[r >> 2]) * fa[r & 3]; if (diag && mrow(r, h5) > l31) v = 0.f; sacc[r] = v; }
#pragma unroll
            for (int s2 = 0; s2 < 2; ++s2) {
                const bf16x8v_ pf = __builtin_bit_cast(bf16x8v_, (v4u){cvtpk_(sacc[8 * s2 + 0], sacc[8 * s2 + 1]), cvtpk_(sacc[8 * s2 + 2], sacc[8 * s2 + 3]), cvtpk_(sacc[8 * s2 + 4], sacc[8 * s2 + 5]), cvtpk_(sacc[8 * s2 + 6], sacc[8 * s2 + 7])});
#pragma unroll
                for (int dvt = 0; dvt < 2; ++dvt) { const LAS unsigned short* vp_ = Vt + (64 * dvh + 32 * dvt + l31) * 132 + 32 * mt + 16 * s2 + 4 * h5;
                    const unsigned long long lo = *(const LAS unsigned long long*)vp_, hi = *(const LAS unsigned long long*)(vp_ + 8);
                    oacc[dvt] = __builtin_amdgcn_mfma_f32_32x32x16_bf16(__builtin_bit_cast(bf16x8v_, (v4u){(unsigned)lo, (unsigned)(lo >> 32), (unsigned)hi, (unsigned)(hi >> 32)}), pf, oacc[dvt], 0, 0, 0); }
            }
        }
        const int etok = tid >> 2, eq = tid & 3;
        v4u rgv[4], gav[4], mwv[4]; f32x4 gnv[4][2];
        { const size_t et = (size_t)tok0 + etok; const int ch0 = h * 128 + 32 * eq;
#pragma unroll
          for (int i = 0; i < 4; ++i) { rgv[i] = *(const GAS v4u*)(projA + et * NA + PA_RG + ch0 + 8 * i); gav[i] = *(const GAS v4u*)(projA + et * NA + PA_GA + ch0 + 8 * i); mwv[i] = *(const GAS v4u*)(merged + et * D + ch0 + 8 * i);
              gnv[i][0] = *(const GAS f32x4*)(gn_g + ch0 + 8 * i); gnv[i][1] = *(const GAS f32x4*)(gn_g + ch0 + 8 * i + 4); } }
        {
            const float qw_ = __builtin_amdgcn_exp2f((float)(32 * ct + l31 + 1) * l2g);
#pragma unroll
            for (int dvt = 0; dvt < 2; ++dvt) { f32x16v_ cacc;
#pragma unroll
                for (int r = 0; r < 16; ++r) cacc[r] = 0.f;
#pragma unroll
                for (int s_ = 0; s_ < 4; ++s_) { const bf16x8v_ sf = *(const LAS bf16x8v_*)(St + (64 * dvh + 32 * dvt + l31) * 72 + 16 * s_ + 8 * h5); cacc = __builtin_amdgcn_mfma_f32_32x32x16_bf16(sf, qf[s_], cacc, 0, 0, 0); }
#pragma unroll
                for (int r = 0; r < 16; ++r) oacc[dvt][r] += cacc[r] * qw_; }
        }
        float s1 = 0.f, s2 = 0.f;
#pragma unroll
        for (int dvt = 0; dvt < 2; ++dvt)
#pragma unroll
            for (int r = 0; r < 16; ++r) { const float v = oacc[dvt][r]; s1 += v; s2 += v * v; }
        s1 += __shfl_xor(s1, 32); s2 += __shfl_xor(s2, 32);
        if (h5 == 0) { Xs[(dvh * 128 + 32 * ct + l31) * 2] = s1; Xs[(dvh * 128 + 32 * ct + l31) * 2 + 1] = s2; }
        LDS_BARRIER();
        { LAS float* Ot = (LAS float*)lds;
#pragma unroll
          for (int dvt = 0; dvt < 2; ++dvt)
#pragma unroll
              for (int g_ = 0; g_ < 4; ++g_) *(LAS f32x4*)(Ot + (32 * ct + l31) * 132 + 64 * dvh + 32 * dvt + 8 * g_ + 4 * h5) = (f32x4){oacc[dvt][4 * g_ + 0], oacc[dvt][4 * g_ + 1], oacc[dvt][4 * g_ + 2], oacc[dvt][4 * g_ + 3]};
          LDS_BARRIER();
          const float t1_ = Xs[etok * 2] + Xs[(128 + etok) * 2], t2_ = Xs[etok * 2 + 1] + Xs[(128 + etok) * 2 + 1];
          const float mu = t1_ * (1.f / 128.f); const float var = fmaxf(t2_ * (1.f / 128.f) - mu * mu, 0.f); const float rs = rsqrtf(var + EPS);
          const size_t et = (size_t)tok0 + etok; const int ch0 = h * 128 + 32 * eq; bf16* mp = merged + et * D + ch0;
#pragma unroll
          for (int i = 0; i < 4; ++i) { const f32x4 oa = *(const LAS f32x4*)(Ot + etok * 132 + 32 * eq + 8 * i), ob = *(const LAS f32x4*)(Ot + etok * 132 + 32 * eq + 8 * i + 4);
              const f32x4 ga_ = gnv[i][0], gb_ = gnv[i][1];
              float rgf[8], gaf[8], mwf[8]; unpack8(rgv[i], rgf); unpack8(gav[i], gaf); unpack8(mwv[i], mwf);
              float y[8];
#pragma unroll
              for (int j = 0; j < 4; ++j) { y[j] = (oa[j] - mu) * rs * ga_[j] * siluf_(rgf[j]) * sigmoidf_(gaf[j]) + mwf[j]; y[4 + j] = (ob[j] - mu) * rs * gb_[j] * siluf_(rgf[4 + j]) * sigmoidf_(gaf[4 + j]) + mwf[4 + j]; }
              *(GAS v4u*)(mp + 8 * i) = (v4u){cvtpk_(y[0], y[1]), cvtpk_(y[2], y[3]), cvtpk_(y[4], y[5]), cvtpk_(y[6], y[7])}; } }
        LDS_BARRIER();
    }
#undef R3_LOAD
}

template <int N, int K, int J> __device__ __forceinline__ void bitonic_step(float (&a)[N]) {
#pragma unroll
    for (int i = 0; i < N; ++i) { const int l = i ^ J; if (l > i) { const bool up = ((i & K) == 0); const float lo = fminf(a[i], a[l]), hi = fmaxf(a[i], a[l]); a[i] = up ? hi : lo; a[l] = up ? lo : hi; } }
}
__device__ __forceinline__ void sort16_desc(float (&a)[16]) {
#define CE_(i, j) { const float hi_ = fmaxf(a[i], a[j]), lo_ = fminf(a[i], a[j]); a[i] = hi_; a[j] = lo_; }
    CE_(0, 13) CE_(1, 12) CE_(2, 15) CE_(3, 14) CE_(4, 8) CE_(5, 6) CE_(7, 11) CE_(9, 10)
    CE_(0, 5) CE_(1, 7) CE_(2, 9) CE_(3, 4) CE_(6, 13) CE_(8, 14) CE_(10, 15) CE_(11, 12)
    CE_(0, 1) CE_(2, 3) CE_(4, 5) CE_(6, 8) CE_(7, 9) CE_(10, 11) CE_(12, 13) CE_(14, 15)
    CE_(0, 2) CE_(1, 3) CE_(4, 10) CE_(5, 11) CE_(6, 7) CE_(8, 9) CE_(12, 14) CE_(13, 15)
    CE_(1, 2) CE_(3, 12) CE_(4, 6) CE_(5, 7) CE_(8, 10) CE_(9, 11) CE_(13, 14)
    CE_(1, 4) CE_(2, 6) CE_(5, 8) CE_(7, 10) CE_(9, 13) CE_(11, 14)
    CE_(2, 4) CE_(3, 6) CE_(9, 12) CE_(11, 13)
    CE_(3, 5) CE_(6, 8) CE_(7, 9) CE_(10, 12)
    CE_(3, 4) CE_(5, 6) CE_(7, 8) CE_(9, 10) CE_(11, 12)
    CE_(6, 7) CE_(8, 9)
#undef CE_
}
__device__ __forceinline__ void merge16_desc(float (&a)[16]) { bitonic_step<16, 16, 8>(a); bitonic_step<16, 16, 4>(a); bitonic_step<16, 16, 2>(a); bitonic_step<16, 16, 1>(a); }
__device__ __forceinline__ void top16_merge(float (&a)[16], const float (&b)[16]) {
#pragma unroll
    for (int i = 0; i < 16; ++i) a[i] = fmaxf(a[i], b[15 - i]);
    merge16_desc(a);
}
__device__ __forceinline__ void top16_xlane(float (&a)[16]) {
    float b[16];
#pragma unroll
    for (int i = 0; i < 16; ++i) b[i] = __shfl_xor(a[i], 32);
    top16_merge(a, b);
}
typedef float f32x16v __attribute__((ext_vector_type(16)));
typedef short bf16x8v __attribute__((ext_vector_type(8)));
__device__ __forceinline__ void peer_scores_top16(const LAS unsigned short* Ks, const bf16x8v (&qfr)[8]  , float (&top)[16], int lane) {
    f32x16v acc[4];
#pragma unroll
    for (int t = 0; t < 4; ++t)
#pragma unroll
        for (int r = 0; r < 16; ++r) acc[t][r] = 0.f;
    const LAS unsigned short* kp = Ks + (lane & 31) * 136 + 8 * (lane >> 5);
#pragma unroll
    for (int s_ = 0; s_ < 8; ++s_) {
#pragma unroll
        for (int t = 0; t < 4; ++t) { const bf16x8v kf = *(const LAS bf16x8v*)(kp + t * 32 * 136 + 16 * s_); acc[t] = __builtin_amdgcn_mfma_f32_32x32x16_bf16(kf, qfr[s_], acc[t], 0, 0, 0); } }
    float lst[4][16];
#pragma unroll
    for (int t = 0; t < 4; ++t) {
#pragma unroll
        for (int r = 0; r < 16; ++r) { const unsigned key = (unsigned)(32 * t + (r & 3) + 8 * (r >> 2) + 4 * (lane >> 5)); const float xf_ = acc[t][r];
            lst[t][r] = __builtin_bit_cast(float, (__builtin_bit_cast(unsigned, xf_) & ~0x7Fu) | key); }
        sort16_desc(lst[t]);
    }
    top16_merge(lst[0], lst[1]); top16_merge(lst[2], lst[3]); top16_merge(lst[0], lst[2]);
#pragma unroll
    for (int i = 0; i < 16; ++i) top[i] = lst[0][i];
    top16_xlane(top);
}
__device__ __forceinline__ void phase_peer_topk2(const bf16* qp, const bf16* k1b, const bf16* k2b, int* idxo, float* gateo, LAS unsigned char* lds, int vcu, int G, int tid) {
    const int lane = tid & 63, wave = __builtin_amdgcn_readfirstlane(tid >> 6);
    LAS unsigned short* K1s = (LAS unsigned short*)lds; LAS unsigned short* K2s = (LAS unsigned short*)(lds + 34816);
    const int h5 = lane >> 5;
    int hcur = -1;
    for (int u = vcu; u < 1024; u += G) {
        const int h = u & 7, tb = u >> 3;
        if (h != hcur) {
            __syncthreads();
            v4u kk1[4], kk2[4];
#pragma unroll
            for (int i = 0; i < 4; ++i) { const int idx = tid + NTHR * i, row = idx >> 4, c8 = idx & 15;
                kk1[i] = *(const GAS v4u*)(k1b + ((size_t)h * 128 + row) * 128 + c8 * 8); kk2[i] = *(const GAS v4u*)(k2b + ((size_t)h * 128 + row) * 128 + c8 * 8); }
            asm volatile("" ::: "memory");
#pragma unroll
            for (int i = 0; i < 4; ++i) { const int idx = tid + NTHR * i, row = idx >> 4, c8 = idx & 15;
                *(LAS v4u*)(K1s + row * 136 + c8 * 8) = kk1[i]; *(LAS v4u*)(K2s + row * 136 + c8 * 8) = kk2[i]; }
            __syncthreads(); hcur = h;
        }
        const size_t tok = (size_t)tb * 256 + wave * 32 + (lane & 31);
        const bf16* qrow = qp + tok * NQP + h * 256 + 8 * h5;
        bf16x8v qa[8], qb[8];
#pragma unroll
        for (int s_ = 0; s_ < 8; ++s_) { qa[s_] = *(const GAS bf16x8v*)(qrow + 16 * s_); qb[s_] = *(const GAS bf16x8v*)(qrow + 128 + 16 * s_); }
        float v1[16], v2[16];
        peer_scores_top16(K1s, qa, v1, lane);
        peer_scores_top16(K2s, qb, v2, lane);
        float p[16], q[16]; unsigned pid[16], qid[16];
#pragma unroll
        for (int i = 0; i < 16; ++i) { const float a1_ = v1[i], a2_ = v2[i]; p[i] = h5 ? a2_ : a1_; q[i] = h5 ? a1_ : a2_;
            pid[i] = (__builtin_bit_cast(unsigned, p[i]) & 0x7Fu) << (h5 ? 0 : 7); qid[i] = (__builtin_bit_cast(unsigned, q[i]) & 0x7Fu) << (h5 ? 7 : 0); }
        float c0[16], c1[16]; const float NEGV = -3.0e38f;
#pragma unroll
        for (int i = 0; i < 16; ++i) { c0[i] = NEGV; c1[i] = NEGV; }
        {
            constexpr int NP = 27; constexpr int PA[NP] = {0, 0, 0, 0, 0, 0, 0, 0, 0, 0, 0, 0, 0, 0, 0, 0, 1, 1, 1, 1, 1, 1, 1, 2, 2, 2, 3}; constexpr int PB[NP] = {0, 1, 2, 3, 4, 5, 6, 7, 8, 9, 10, 11, 12, 13, 14, 15, 1, 2, 3, 4, 5, 6, 7, 2, 3, 4, 3};
#pragma unroll
            for (int n = 0; n < NP; ++n) {
                float sv_ = p[PA[n]] + q[PB[n]];
                sv_ = __builtin_bit_cast(float, (__builtin_bit_cast(unsigned, sv_) & ~0x3FFFu) | pid[PA[n]] | qid[PB[n]]);
                if (PA[n] == PB[n]) sv_ = h5 ? NEGV : sv_;
                if (n < 16) c0[n] = sv_; else c1[n - 16] = sv_;
            }
        }
        sort16_desc(c0); sort16_desc(c1); top16_merge(c0, c1); top16_xlane(c0);
        float val[16]; float sm = 0.f;
        { const float mx = __builtin_bit_cast(float, (__builtin_bit_cast(unsigned, c0[0]) & ~0x3FFFu) | 0x2000u);
#pragma unroll
          for (int i = 0; i < 16; ++i) { const float vv = __builtin_bit_cast(float, (__builtin_bit_cast(unsigned, c0[i]) & ~0x3FFFu) | 0x2000u); val[i] = __expf(vv - mx); sm += val[i]; } }
        const float inv = 1.f / sm;
        v4u oi[2]; f32x4 og[2];
#pragma unroll
        for (int k = 0; k < 8; ++k) { const float cl_ = c0[k], ch_ = c0[8 + k], vl_ = val[k], vh_ = val[8 + k]; const float cc = h5 ? ch_ : cl_; const float gg = (h5 ? vh_ : vl_) * inv;
            oi[k >> 2][k & 3] = __builtin_bit_cast(unsigned, cc) & 0x3FFFu; og[k >> 2][k & 3] = gg; }
        int* ip = idxo + tok * 128 + h * 16 + 8 * h5; float* gp = gateo + tok * 128 + h * 16 + 8 * h5;
        *(GAS v4u*)ip = oi[0]; *(GAS v4u*)(ip + 4) = oi[1]; *(GAS f32x4*)gp = og[0]; *(GAS f32x4*)(gp + 4) = og[1];
    }
    __syncthreads();
}


__device__ __forceinline__ void cvt_rows_fp8(const float* src, unsigned char* dst, float* inv_scale, int vcu, int G, int tid) {
    const int lane = tid & 63, wave = __builtin_amdgcn_readfirstlane(tid >> 6);
    const int gw = vcu * NWAVES + wave, NGW = G * NWAVES;
    constexpr int RI = 4;
    for (int row0 = gw * RI; row0 < NEXP; row0 += NGW * RI) {
        f32x4 v[RI][4]; float m[RI];
#pragma unroll
        for (int r = 0; r < RI; ++r) { const int row = row0 + r; const GAS f32x4* p = (const GAS f32x4*)(src + (size_t)(row < NEXP ? row : gw) * D + 16 * lane);
#pragma unroll
            for (int j = 0; j < 4; ++j) v[r][j] = p[j]; }
#pragma unroll
        for (int r = 0; r < RI; ++r) { float a = 0.f;
#pragma unroll
            for (int j = 0; j < 4; ++j) a = fmaxf(a, fmaxf(fmaxf(fabsf(v[r][j].x), fabsf(v[r][j].y)), fmaxf(fabsf(v[r][j].z), fabsf(v[r][j].w))));
            m[r] = a; }
#pragma unroll
        for (int r = 0; r < RI; ++r) m[r] = wave_max(m[r]);
#pragma unroll
        for (int r = 0; r < RI; ++r) { const int row = row0 + r; if (row < NEXP) {
            const int e = (int)((__builtin_bit_cast(unsigned, m[r]) >> 23) & 0xffu) - 127;
            const bool ok = (m[r] > 1e-30f);
            const float sc = ok ? __builtin_bit_cast(float, (unsigned)(127 + 7 - e) << 23) : 1.f, inv = ok ? __builtin_bit_cast(float, (unsigned)(127 - 7 + e) << 23) : 1.f;
            v4u o;
#pragma unroll
            for (int j = 0; j < 4; ++j) { int w = __builtin_amdgcn_cvt_pk_fp8_f32(v[r][j].x * sc, v[r][j].y * sc, 0, false); w = __builtin_amdgcn_cvt_pk_fp8_f32(v[r][j].z * sc, v[r][j].w * sc, w, true); o[j] = (unsigned)w; }
            *(GAS v4u*)(dst + (size_t)row * D + 16 * lane) = o;
            if (lane == 0) inv_scale[row] = inv; } }
    }
}
__device__ __forceinline__ void fp8x16_to_f32(const v4u r, f32x2v* f) {
#pragma unroll
    for (int j = 0; j < 4; ++j) { f[2 * j] = __builtin_amdgcn_cvt_pk_f32_fp8((int)r[j], false); f[2 * j + 1] = __builtin_amdgcn_cvt_pk_f32_fp8((int)r[j], true); }
}
__device__ __forceinline__ float erf_as(float x) {
    const float ax = fabsf(x), t = __builtin_amdgcn_rcpf(fmaf(0.3275911f, ax, 1.f));
    const float p = t * fmaf(t, fmaf(t, fmaf(t, fmaf(t, 1.061405429f, -1.453152027f), 1.421413741f), -0.284496736f), 0.254829592f);
    const float r = 1.f - p * __builtin_amdgcn_exp2f(-ax * ax * 1.4426950408889634f);
    return copysignf(r, x);
}
constexpr int GT = 6;
__device__ __forceinline__ float swap_add32(float lo, float hi) { const v2u_ s = __builtin_amdgcn_permlane32_swap(__builtin_bit_cast(unsigned, lo), __builtin_bit_cast(unsigned, hi), false, false); const unsigned a_ = s.x, b_ = s.y; return __builtin_bit_cast(float, a_) + __builtin_bit_cast(float, b_); }
__device__ __forceinline__ float swap_add16(float lo, float hi) { const v2u_ s = __builtin_amdgcn_permlane16_swap(__builtin_bit_cast(unsigned, lo), __builtin_bit_cast(unsigned, hi), false, false); const unsigned a_ = s.x, b_ = s.y; return __builtin_bit_cast(float, a_) + __builtin_bit_cast(float, b_); }
template <int W, int LB> __device__ __forceinline__ void bfly8_step(float (&part)[8], int lane) {
    const bool up = (lane & LB) != 0;
#pragma unroll
    for (int j = 0; j < W; ++j) { const float lo = part[j], hi = part[j + W]; const float send = up ? lo : hi, keep = up ? hi : lo; part[j] = keep + __shfl_xor(send, LB); }
}
__device__ __forceinline__ void phase_peer_gather_lp(const bf16* xn2, const int* idx, const float* gate, const unsigned char* ub, const unsigned char* vb, const float* su, const float* sv,
                                                     bf16* x, float* outf, const float* g2, bool last, const float* ng, const float* nsc, const float* nsh, bf16* xn_next, LAS unsigned char* lds, int vcu, int G, int tid) {
    const int lane = tid & 63, wave = __builtin_amdgcn_readfirstlane(tid >> 6);
    const int gw = vcu * NWAVES + wave, NGW = G * NWAVES;
    constexpr int WB = GT * 1024 + GT * 512;
    LAS int* SE = (LAS int*)(lds + wave * WB); LAS float* SG = (LAS float*)(lds + wave * WB + GT * 512); LAS float* RED = (LAS float*)(lds + wave * WB + GT * 1024);
    const int jj = ((lane >> 5) & 1) * 4 + ((lane >> 4) & 1) * 2 + ((lane >> 3) & 1);
    const unsigned long long below = (1ull << lane) - 1ull;
    const int TPW = M / NGW;
    for (int tb = 0; tb * GT < TPW; ++tb) {
        const int nt = (TPW - tb * GT < GT) ? TPW - tb * GT : GT;
        v4u hp[GT][2]; f32x2v y2[GT][8];
#pragma unroll
        for (int t = 0; t < GT; ++t) { hp[t][0] = (v4u){0u, 0u, 0u, 0u}; hp[t][1] = hp[t][0]; }
#pragma unroll
        for (int t = 0; t < GT; ++t) if (t < nt) {
            const int tok = gw + (tb * GT + t) * NGW;
            int ls = lane; asm volatile("" : "+v"(ls));
            { const bf16* hr = xn2 + (size_t)tok * D + 16 * ls; hp[t][0] = *(const GAS v4u*)hr; hp[t][1] = *(const GAS v4u*)(hr + 8); }
            const int e0 = idx[(size_t)tok * 128 + ls], e1 = idx[(size_t)tok * 128 + 64 + ls];
            const float g0 = gate[(size_t)tok * 128 + ls], g1 = gate[(size_t)tok * 128 + 64 + ls];
            {
                const int k0 = e0 >> 10, k1 = e1 >> 10;
                unsigned long long m0 = ~0ull, m1 = ~0ull, x10 = ~0ull;
#pragma unroll
                for (int bb = 0; bb < 4; ++bb) { const bool b0 = (k0 >> bb) & 1, b1 = (k1 >> bb) & 1; const unsigned long long B0 = __ballot(b0), B1 = __ballot(b1);
                    m0 &= b0 ? B0 : ~B0; m1 &= b1 ? B1 : ~B1; x10 &= b1 ? B0 : ~B0; }
                const int r0 = __popcll(m0 & below), c0 = __popcll(m0), r1 = __popcll(m1 & below), c1 = __popcll(m1), c01 = __popcll(x10);
                LAS int* H = (LAS int*)(RED + t * 128);
                if (lane < 32) H[lane] = 0;
                if (r0 == 0) H[k0] = c0;
                if (r1 == 0) H[16 + k1] = c1;
                const int tot = H[lane & 15] + H[16 + (lane & 15)];
                asm volatile("s_waitcnt lgkmcnt(0)" ::: "memory");
                int inc = tot;
                inc += __builtin_amdgcn_update_dpp(0, inc, 0x111, 0xf, 0xf, true); inc += __builtin_amdgcn_update_dpp(0, inc, 0x112, 0xf, 0xf, true);
                inc += __builtin_amdgcn_update_dpp(0, inc, 0x114, 0xf, 0xf, true); inc += __builtin_amdgcn_update_dpp(0, inc, 0x118, 0xf, 0xf, true);
                if (lane < 16) H[32 + lane] = inc - tot;
                const int pos0 = H[32 + k0] + r0, pos1 = H[32 + k1] + c01 + r1;
                asm volatile("s_waitcnt lgkmcnt(0)" ::: "memory");
                SE[t * 128 + pos0] = e0; SG[t * 128 + pos0] = g0; SE[t * 128 + pos1] = e1; SG[t * 128 + pos1] = g1;
            }
        }
        asm volatile("s_waitcnt lgkmcnt(0)" ::: "memory");
#pragma unroll 1
        for (int c = 0; c < 16; ++c) {
            if ((c & 3) == 0) __builtin_amdgcn_s_barrier();
#pragma unroll
          for (int th = 0; th < GT; th += 2) if (th < nt) {
            v4u rr[2][8];
#pragma unroll
            for (int t2 = 0; t2 < 2; ++t2) { const int sel = SE[(th + t2) * 128 + 8 * c + (lane & 7)]; const int l0 = 0;
#pragma unroll
                for (int i = 0; i < 8; ++i) { const int e = rl_i(sel, l0 + i); rr[t2][i] = *(const GAS v4u*)(ub + (size_t)e * D + 16 * lane); } }
#pragma unroll
            for (int t2 = 0; t2 < 2; ++t2) { const int t = th + t2;
                float part[8]; f32x2v hx[8];
                { float hf[16]; unpack8(hp[t][0], hf); unpack8(hp[t][1], hf + 8);
#pragma unroll
                  for (int j = 0; j < 8; ++j) hx[j] = (f32x2v){hf[2 * j], hf[2 * j + 1]}; }
#pragma unroll
                for (int i = 0; i < 8; ++i) { f32x2v uf[8]; fp8x16_to_f32(rr[t2][i], uf); f32x2v a2 = hx[0] * uf[0];
#pragma unroll
                    for (int q = 1; q < 8; ++q) a2 += hx[q] * uf[q];
                    part[i] = a2.x + a2.y; }
#pragma unroll
                for (int j = 0; j < 4; ++j) part[j] = swap_add32(part[j], part[j + 4]);
                part[0] = swap_add16(part[0], part[2]); part[1] = swap_add16(part[1], part[3]);
                { const float a_ = part[0] + dpp_f<0x128>(part[0]), b_ = part[1] + dpp_f<0x128>(part[1]); part[0] = (lane & 8) ? b_ : a_; }
                float sd_ = part[0]; sd_ += dpp_f<0x141>(sd_); sd_ += dpp_f<0xB1>(sd_); sd_ += dpp_f<0x4E>(sd_);
                if ((lane & 7) == 0) RED[(t * 16 + c) * 8 + jj] = sd_;
            }
          }
        }
        asm volatile("s_waitcnt lgkmcnt(0)" ::: "memory");
        float scu0[GT], scu1[GT], scv0[GT], scv1[GT];
#pragma unroll
        for (int t = 0; t < GT; ++t) { scu0[t] = scu1[t] = scv0[t] = scv1[t] = 0.f; if (t < nt) { const int s0_ = SE[t * 128 + lane], s1_ = SE[t * 128 + 64 + lane]; scu0[t] = su[s0_]; scu1[t] = su[s1_]; scv0[t] = sv[s0_]; scv1[t] = sv[s1_]; } }
#pragma unroll
        for (int t = 0; t < GT; ++t) if (t < nt) {
            const float d0 = RED[t * 128 + lane] * scu0[t], d1 = RED[t * 128 + 64 + lane] * scu1[t];
            const float c0_ = 0.5f * d0 * (1.f + erf_as(d0 * 0.70710678118654752f)) * scv0[t] * SG[t * 128 + lane];
            const float c1_ = 0.5f * d1 * (1.f + erf_as(d1 * 0.70710678118654752f)) * scv1[t] * SG[t * 128 + 64 + lane];
            asm volatile("s_waitcnt lgkmcnt(0)" ::: "memory");
            RED[t * 128 + lane] = c0_; RED[t * 128 + 64 + lane] = c1_;
        }
        asm volatile("s_waitcnt lgkmcnt(0)" ::: "memory");
#pragma unroll
        for (int t = 0; t < GT; ++t)
#pragma unroll
            for (int j = 0; j < 8; ++j) y2[t][j] = (f32x2v){0.f, 0.f};
#pragma unroll 1
        for (int c = 0; c < 16; ++c) {
            if ((c & 3) == 0) __builtin_amdgcn_s_barrier();
#pragma unroll
          for (int th = 0; th < GT; th += 2) if (th < nt) {
            v4u rr[2][8];
#pragma unroll
            for (int t2 = 0; t2 < 2; ++t2) { const int sel = SE[(th + t2) * 128 + 8 * c + (lane & 7)]; const int l0 = 0;
#pragma unroll
                for (int i = 0; i < 8; ++i) { const int e = rl_i(sel, l0 + i); rr[t2][i] = *(const GAS v4u*)(vb + (size_t)e * D + 16 * lane); } }
#pragma unroll
            for (int t2 = 0; t2 < 2; ++t2) { const int t = th + t2;
                const float coef = RED[(t * 16 + c) * 8 + jj];
#pragma unroll
                for (int i = 0; i < 8; ++i) { f32x2v vf[8]; fp8x16_to_f32(rr[t2][i], vf); const float cf = rl_f(coef, 32 * ((i >> 2) & 1) + 16 * ((i >> 1) & 1) + 8 * (i & 1));
#pragma unroll
                    for (int q = 0; q < 8; ++q) y2[t][q] += vf[q] * cf; }
            }
          }
        }
        asm volatile("s_waitcnt lgkmcnt(0)" ::: "memory");
        int lt = lane; asm volatile("" : "+v"(lt));
#pragma unroll
        for (int t = 0; t < GT; ++t) if (t < nt) {
            const int tok = gw + (tb * GT + t) * NGW; const int b = tok >> 12;
            bf16* xr = x + (size_t)tok * XP + 16 * lt; const float* gr = g2 + (size_t)b * MODW + 16 * lt;
            const float* scp = nsc + (size_t)b * MODW + 16 * lt; const float* shp = nsh + (size_t)b * MODW + 16 * lt;
            const v4u xw0 = *(const GAS v4u*)xr, xw1 = *(const GAS v4u*)(xr + 8);
            f32x4 gav[4];
#pragma unroll
            for (int q = 0; q < 4; ++q) gav[q] = *(const GAS f32x4*)(gr + 4 * q);
            asm volatile("" ::: "memory");
            f32x4 xv[4]; float ss = 0.f;
            { float xf[16]; unpack8(xw0, xf); unpack8(xw1, xf + 8);
#pragma unroll
            for (int q = 0; q < 4; ++q) { const f32x4 xa = (f32x4){xf[4 * q], xf[4 * q + 1], xf[4 * q + 2], xf[4 * q + 3]};
                const f32x4 yy = (f32x4){y2[t][2 * q].x, y2[t][2 * q].y, y2[t][2 * q + 1].x, y2[t][2 * q + 1].y};
                xv[q] = xa + gav[q] * yy; ss += (xv[q].x * xv[q].x + xv[q].y * xv[q].y) + (xv[q].z * xv[q].z + xv[q].w * xv[q].w); } }
            if (last) {
                f32x4 ngv[4];
#pragma unroll
                for (int q = 0; q < 4; ++q) ngv[q] = *(const GAS f32x4*)(ng + 16 * lt + 4 * q);
                asm volatile("" ::: "memory");
                const float rstd = rsqrtf(wave_sum(ss) * (1.f / D) + EPS);
                float* orow = outf + (size_t)tok * D + 16 * lt;
#pragma unroll
                for (int q = 0; q < 4; ++q) *(GAS f32x4*)(orow + 4 * q) = xv[q] * rstd * ngv[q];
            } else {
                f32x4 ngv[4], scv_[4], shv_[4];
#pragma unroll
                for (int q = 0; q < 4; ++q) { ngv[q] = *(const GAS f32x4*)(ng + 16 * lt + 4 * q); scv_[q] = *(const GAS f32x4*)(scp + 4 * q); shv_[q] = *(const GAS f32x4*)(shp + 4 * q); }
                asm volatile("" ::: "memory");
                const float rstd = rsqrtf(wave_sum(ss) * (1.f / D) + EPS);
                bf16* orow = xn_next + (size_t)tok * D + 16 * lt;
                unsigned pk[8], px[8];
#pragma unroll
                for (int q = 0; q < 4; ++q) { px[2 * q] = pk2(xv[q].x, xv[q].y); px[2 * q + 1] = pk2(xv[q].z, xv[q].w);
                    const f32x4 hn = (xv[q] * rstd * ngv[q]) * (scv_[q] + 1.0f) + shv_[q]; pk[2 * q] = pk2(hn.x, hn.y); pk[2 * q + 1] = pk2(hn.z, hn.w); }
                *(GAS v4u*)xr = (v4u){px[0], px[1], px[2], px[3]}; *(GAS v4u*)(xr + 8) = (v4u){px[4], px[5], px[6], px[7]};
                *(GAS v4u*)orow = (v4u){pk[0], pk[1], pk[2], pk[3]}; *(GAS v4u*)(orow + 8) = (v4u){pk[4], pk[5], pk[6], pk[7]};
            }
        }
    }
}

constexpr int PH_PER_LAYER = 11, N_PHASES = 2 + DEPTH * PH_PER_LAYER;
#ifndef PHASE_MASK
#define PHASE_MASK 0xFFFF
#endif
#define PM(k) ((PHASE_MASK >> (k)) & 1)
#ifndef MK_PER_PHASE
#define MK_PER_PHASE 0
#endif
__global__ void __launch_bounds__(NTHR, 2) mk_fwd(Args args) {
    extern __shared__ __attribute__((aligned(16))) unsigned char lds_raw[];
    LAS unsigned char* lds = (LAS unsigned char*)lds_raw;
    const int tid0 = threadIdx.x;
    const int G = gridDim.x; const int bx = blockIdx.x; const int vcu = (G % 8 == 0) ? (bx % 8) * (G / 8) + bx / 8 : bx;
    for (int u = tid0; u < (LDS_BYTES - LDSCTL_OFF) / 4; u += NTHR) ((LAS unsigned*)(lds + LDSCTL_OFF))[u] = 0u;
    __syncthreads();
    XcdBarrier bar; bar.bar = (unsigned*)(args.ws + WS_CTL) + CW_BAR; bar.x = 0; bar.st = nullptr;
    if (!MK_PER_PHASE) bar = xcd_barrier_post((unsigned*)(args.ws + WS_CTL) + CW_BAR, (volatile LAS unsigned*)(lds + LDSCTL_OFF) + 8);
    for (int p = args.ph_lo; p < args.ph_hi; ++p) {
        int tid = tid0; asm volatile("" : "+v"(tid));
        unsigned char* ws = args.ws; asm volatile("" : "+s"(ws));
        float* modp = (float*)(ws + WS_MOD);
        int l = 0, r = -1;
        if (p >= 2) { l = (p - 2) / PH_PER_LAYER; r = (p - 2) % PH_PER_LAYER; }
        const float* modl = modp + (size_t)l * 8 * MODW;
        if (p == 0) { if (PM(0)) phase_prologue(args, lds, vcu, G, tid); }
        else if (p == 1 || r == 7) {
            if (PM(1)) {
                if (p == 1) phase_norm(args.in[0], args.in[5], modl + 1024, modl + 0, (bf16*)(ws + WS_XN), vcu, G, tid);
                else { phase_norm_b((const bf16*)args.out, args.in[6] + l * D, modl + 4096, modl + 3072, (bf16*)(ws + WS_XN), vcu, G, tid); cvt_rows_fp8(args.in[14] + (size_t)l * NEXP * D, ws + WS_U8, (float*)(ws + WS_SU), vcu, G, tid);
                    cvt_rows_fp8(args.in[15] + (size_t)l * NEXP * D, ws + WS_V8, (float*)(ws + WS_SV), vcu, G, tid); }
            }
        }
        else if (r == 0 || r == 2 || r == 8) {
            if (PM(2)) {
                const bf16* Bt; int N; bf16* O;
                if (r == 0) { Bt = (const bf16*)(ws + WS_WIN) + (size_t)l * NIN * D + (size_t)NA * D; N = NB; O = (bf16*)(ws + WS_PROJ); }
                else if (r == 2) { Bt = (const bf16*)(ws + WS_WIN) + (size_t)l * NIN * D; N = NA; O = (bf16*)(ws + WS_PROJ); }
                else { Bt = (const bf16*)(ws + WS_WQ) + (size_t)l * NQP * D; N = NQP; O = (bf16*)(ws + WS_QP); }
                pg8::Gemm g{(const bf16*)(ws + WS_XN), Bt, M, N, D}; pg8::StaticOrder S; S.init(M, N, G, bx);
                pg8::EpiBf16 E{O, N};
                pg8::gemm_phase<pg8::EpiBf16, pg8::StaticOrder, PG8_ALIGN, PG8_SP2>(lds, g, S, E);
            }
        }
        else if (r == 1) { if (PM(3)) phase_swa_mfma((const bf16*)(ws + WS_PROJ), (const unsigned*)(ws + WS_ROPE_A), args.in[9] + l * 16, (bf16*)(ws + WS_MERGED), lds, vcu, G, tid); }
        else if (r == 3) { if (PM(4)) phase_ret_kv_mfma((const bf16*)(ws + WS_PROJ), (const unsigned*)(ws + WS_ROPE_R), (float*)(ws + WS_XN), lds, vcu, G, tid); }
        else if (r == 4) { if (PM(5)) phase_ret_scan2((const float*)(ws + WS_XN), (bf16*)(ws + WS_PREVT), vcu, G, tid); }
        else if (r == 5) { if (PM(6)) phase_ret_out_mfma((const bf16*)(ws + WS_PROJ), (const unsigned*)(ws + WS_ROPE_R), (const bf16*)(ws + WS_PREVT), args.in[8] + l * D, (bf16*)(ws + WS_MERGED), lds, vcu, G, tid); }
        else if (r == 6) {
            if (PM(7)) {
                pg8::Gemm g{(const bf16*)(ws + WS_MERGED), (const bf16*)(ws + WS_WOUT) + (size_t)l * D * D, M, D, D}; pg8::StaticOrder S; S.init(M, D, G, bx);
                pg8::EpiResGateB E{l == 0 ? (const void*)args.in[0] : (const void*)args.out, l == 0 ? D : XP, l != 0, (pg8::bf16_t*)args.out, XP, modl + 2048, MODW};
                pg8::gemm_phase<pg8::EpiResGateB, pg8::StaticOrder, PG8_ALIGN, PG8_SP2>(lds, g, S, E);
            }
        }
        else if (r == 9) { if (PM(8)) phase_peer_topk2((const bf16*)(ws + WS_QP), (const bf16*)(ws + WS_K1) + (size_t)l * 8 * 128 * 128, (const bf16*)(ws + WS_K2) + (size_t)l * 8 * 128 * 128, (int*)(ws + WS_IDX), (float*)(ws + WS_GATE), lds, vcu, G, tid); }
        else {
            if (PM(9)) {
                const bool last = (l == DEPTH - 1);
                const float* modn = modp + (size_t)(last ? l : l + 1) * 8 * MODW;
                phase_peer_gather_lp((const bf16*)(ws + WS_XN), (const int*)(ws + WS_IDX), (const float*)(ws + WS_GATE), ws + WS_U8, ws + WS_V8, (const float*)(ws + WS_SU), (const float*)(ws + WS_SV), (bf16*)args.out, args.out, modl + 5120,
                                  last, last ? args.in[16] : args.in[5] + (l + 1) * D, modn + 1024, modn + 0, (bf16*)(ws + WS_XN), lds, vcu, G, tid);
            }
        }
        if (!MK_PER_PHASE && p + 1 < args.ph_hi) xcd_barrier(bar);
    }
}

extern "C" void kernel_launch(void* const* d_in, const int* in_sizes, int n_in, void* d_out, int out_size, void* d_ws, size_t ws_size, hipStream_t stream) {
    static int grid = 0;
    if (grid == 0) {
        if (n_in != 17 || in_sizes[0] != M * D || out_size != M * D || ws_size < WS_END) { fprintf(stderr, "kernel_launch: unexpected problem (n_in %d, in0 %d, out %d, ws %zu < %zu); nothing launched\n", n_in, n_in > 0 ? in_sizes[0] : -1, out_size, ws_size, (size_t)WS_END); grid = -1; return; }
        int dev = 0, cus = 0, per_cu = 0;
        if (hipGetDevice(&dev) != hipSuccess || hipDeviceGetAttribute(&cus, hipDeviceAttributeMultiprocessorCount, dev) != hipSuccess) { grid = -1; return; }
        if (hipFuncSetAttribute((const void*)mk_fwd, hipFuncAttributeMaxDynamicSharedMemorySize, LDS_BYTES) != hipSuccess) { fprintf(stderr, "kernel_launch: hipFuncSetAttribute failed\n"); grid = -1; return; }
        if (hipOccupancyMaxActiveBlocksPerMultiprocessor(&per_cu, (const void*)mk_fwd, NTHR, LDS_BYTES) != hipSuccess || per_cu < 1) { fprintf(stderr, "kernel_launch: occupancy query says %d blocks per CU; nothing launched\n", per_cu); (void)hipGetLastError(); grid = -1; return; }
        (void)hipGetLastError();
        if (cus != 256) { fprintf(stderr, "kernel_launch: built for a 256-CU device (MI355X), found %d CUs; nothing launched\n", cus); grid = -1; return; }
        grid = cus;
    }
    if (grid < 0) return;
    if (hipMemsetAsync((char*)d_ws + WS_CTL, 0, CTL_ZERO_BYTES, stream) != hipSuccess) return;
    Args a{};
    for (int i = 0; i < 17; ++i) a.in[i] = (const float*)d_in[i];
    a.out = (float*)d_out; a.ws = (unsigned char*)d_ws;
#if MK_PER_PHASE
    for (int p = 0; p < N_PHASES; ++p) { a.ph_lo = p; a.ph_hi = p + 1; a.li = 0; hipLaunchKernelGGL(mk_fwd, dim3(grid), dim3(NTHR), LDS_BYTES, stream, a); }
#else
    a.ph_lo = 0; a.ph_hi = N_PHASES; a.li = 0;
    hipLaunchKernelGGL(mk_fwd, dim3(grid), dim3(NTHR), LDS_BYTES, stream, a);
#endif
}
```

```cpp
#include <hip/hip_runtime.h>
#include <cstdio>
#include <cstdint>
#include <cmath>
namespace pg8 {
#define PG8_LAS __attribute__((address_space(3)))
typedef unsigned short bf16_t;
typedef short bf16x8 __attribute__((ext_vector_type(8)));
typedef float f32x4 __attribute__((ext_vector_type(4)));
typedef unsigned u32x4 __attribute__((ext_vector_type(4)));
constexpr int BM = 256, BK = 64, HALF = 128, HTB = HALF * BK * 2  , STAGE_BYTES = 8 * HTB, NXCD = 8, WGM = 8;

__host__ __device__ __forceinline__ int lds_byte(int r, int c) { const int st = (r >> 4) * 2 + (c >> 5), rr = r & 15, cc = c & 31, ob = rr * 64 + cc * 2; return st * 1024 + (ob ^ (((ob >> 9) & 1) << 5)); }
__host__ __device__ __forceinline__ void stage_rc(int b, int& R, int& C) { const int st = b / 1024, sb = b % 1024, swz = sb ^ (((sb >> 9) & 1) << 5); R = (st >> 1) * 16 + swz / 64; C = (st & 1) * 32 + (swz % 64) / 2; }
__host__ __device__ __forceinline__ int perm32(int rho) { const int n = rho >> 4, i = rho & 15; return 8 * (i >> 2) + 4 * n + (i & 3); }

struct Unit { int pm, pn; };
struct Gemm { const bf16_t* A; const bf16_t* Bt; int M, N, K; };

struct StaticOrder {
    int nM, nN, nwg, G, c;
    __host__ __device__ void init(int M, int N, int G_, int c_) { nM = M / BM; nN = N / BM; nwg = nM * nN; G = G_; c = c_; }
    __host__ __device__ bool next(int i, Unit& u) const {
        const long L = (long)i * G + c; if (L >= nwg) return false;
        int wgid = (int)L; { const int q = nwg / NXCD, r = nwg % NXCD, xcd = wgid % NXCD, off = wgid / NXCD; wgid = (xcd < r ? xcd * (q + 1) : r * (q + 1) + (xcd - r) * q) + off; }
        const int nig = WGM * nN, gid = wgid / nig, fm = gid * WGM, gsz = (nM - fm) < WGM ? (nM - fm) : WGM;
        u.pm = fm + ((wgid % nig) % gsz); u.pn = (wgid % nig) / gsz; return true;
    }
    __device__ __forceinline__ void a_ready(const Unit&) const {}
    __device__ __forceinline__ void done(const Unit&) const {}
};

__device__ __forceinline__ unsigned cvt_pk_bf16(float lo, float hi) { unsigned r; asm volatile("v_cvt_pk_bf16_f32 %0, %1, %2" : "=v"(r) : "v"(lo), "v"(hi)); return r; }
typedef float f32x2 __attribute__((ext_vector_type(2)));
struct EpiBf16 {
    static constexpr bool PERM = true, AFTER_DRAIN = false;
    bf16_t* O; int ldc;
    __device__ __forceinline__ void operator()(const f32x4 (&acc)[2][2][4][2], const Unit& u, int wr, int wc, int fr, int fq) const {
        const int row0 = u.pm * BM + wr * 64 + fr; const int col0 = u.pn * BM + wc * 32 + 8 * fq;
#pragma unroll
        for (int ai = 0; ai < 2; ++ai)
#pragma unroll
            for (int m = 0; m < 4; ++m) { bf16_t* rowp = O + (size_t)(row0 + ai * HALF + m * 16) * ldc + col0;
#pragma unroll
                for (int bj = 0; bj < 2; ++bj) { const f32x4 v0 = acc[ai][bj][m][0], v1 = acc[ai][bj][m][1];
                    u32x4 w; w.x = cvt_pk_bf16(v0[0], v0[1]); w.y = cvt_pk_bf16(v0[2], v0[3]); w.z = cvt_pk_bf16(v1[0], v1[1]); w.w = cvt_pk_bf16(v1[2], v1[3]);
                    *(u32x4*)(rowp + bj * HALF) = w; } }
    }
};
struct EpiResGate {
    static constexpr bool PERM = false, AFTER_DRAIN = false;
    const float* xin; float* xout; const float* gate; int gate_ld; int ldc;
    __device__ __forceinline__ void operator()(const f32x4 (&acc)[2][2][4][2], const Unit& u, int wr, int wc, int fr, int fq) const {
        const int col0 = u.pn * BM + wc * 32 + 4 * fq; const int b = (u.pm * BM) >> 12;
        f32x4 gv[2][2];
#pragma unroll
        for (int bj = 0; bj < 2; ++bj)
#pragma unroll
            for (int n = 0; n < 2; ++n) gv[bj][n] = *(const f32x4*)(gate + (size_t)b * gate_ld + col0 + bj * HALF + n * 16);
#pragma unroll
        for (int ai = 0; ai < 2; ++ai)
#pragma unroll
            for (int m = 0; m < 4; ++m) { const size_t off = (size_t)(u.pm * BM + ai * HALF + wr * 64 + m * 16 + fr) * ldc + col0;
#pragma unroll
                for (int bj = 0; bj < 2; ++bj)
#pragma unroll
                    for (int n = 0; n < 2; ++n) { const f32x4 xi = *(const f32x4*)(xin + off + bj * HALF + n * 16); *(f32x4*)(xout + off + bj * HALF + n * 16) = xi + gv[bj][n] * acc[ai][bj][m][n]; } }
    }
};
struct EpiResGateB {
    static constexpr bool PERM = true, AFTER_DRAIN = false;
    const void* xin; int ldi; bool in_bf16; bf16_t* xout; int ldo; const float* gate; int gate_ld;
    __device__ __forceinline__ void operator()(const f32x4 (&acc)[2][2][4][2], const Unit& u, int wr, int wc, int fr, int fq) const {
        const int row0 = u.pm * BM + wr * 64 + fr; const int col0 = u.pn * BM + wc * 32 + 8 * fq; const int b = (u.pm * BM) >> 12;
        f32x4 gv[2][2];
#pragma unroll
        for (int bj = 0; bj < 2; ++bj)
#pragma unroll
            for (int n = 0; n < 2; ++n) gv[bj][n] = *(const f32x4*)(gate + (size_t)b * gate_ld + col0 + bj * HALF + n * 4);
        if (in_bf16) {
#pragma unroll
            for (int ai = 0; ai < 2; ++ai) {
                u32x4 w[4][2];
#pragma unroll
                for (int m = 0; m < 4; ++m)
#pragma unroll
                    for (int bj = 0; bj < 2; ++bj) w[m][bj] = *(const u32x4*)((const bf16_t*)xin + (size_t)(row0 + ai * HALF + m * 16) * ldi + col0 + bj * HALF);
                asm volatile("" ::: "memory");
#pragma unroll
                for (int m = 0; m < 4; ++m) { const size_t row = (size_t)(row0 + ai * HALF + m * 16);
#pragma unroll
                    for (int bj = 0; bj < 2; ++bj) { const u32x4 ww = w[m][bj];
                        const f32x4 x0 = {__builtin_bit_cast(float, ww.x << 16), __builtin_bit_cast(float, ww.x & 0xffff0000u), __builtin_bit_cast(float, ww.y << 16), __builtin_bit_cast(float, ww.y & 0xffff0000u)};
                        const f32x4 x1 = {__builtin_bit_cast(float, ww.z << 16), __builtin_bit_cast(float, ww.z & 0xffff0000u), __builtin_bit_cast(float, ww.w << 16), __builtin_bit_cast(float, ww.w & 0xffff0000u)};
                        const f32x4 v0 = x0 + gv[bj][0] * acc[ai][bj][m][0], v1 = x1 + gv[bj][1] * acc[ai][bj][m][1];
                        u32x4 o; o.x = cvt_pk_bf16(v0[0], v0[1]); o.y = cvt_pk_bf16(v0[2], v0[3]); o.z = cvt_pk_bf16(v1[0], v1[1]); o.w = cvt_pk_bf16(v1[2], v1[3]);
                        *(u32x4*)(xout + row * ldo + col0 + bj * HALF) = o; } }
            }
        } else {
#pragma unroll
            for (int ai = 0; ai < 2; ++ai)
#pragma unroll
                for (int mh = 0; mh < 2; ++mh) {
                    f32x4 xa[2][2][2];
#pragma unroll
                    for (int m2 = 0; m2 < 2; ++m2)
#pragma unroll
                        for (int bj = 0; bj < 2; ++bj) { const float* xp = (const float*)xin + (size_t)(row0 + ai * HALF + (2 * mh + m2) * 16) * ldi + col0 + bj * HALF; xa[m2][bj][0] = *(const f32x4*)xp; xa[m2][bj][1] = *(const f32x4*)(xp + 4); }
                    asm volatile("" ::: "memory");
#pragma unroll
                    for (int m2 = 0; m2 < 2; ++m2) { const int m = 2 * mh + m2; const size_t row = (size_t)(row0 + ai * HALF + m * 16);
#pragma unroll
                        for (int bj = 0; bj < 2; ++bj) {
                            const f32x4 v0 = xa[m2][bj][0] + gv[bj][0] * acc[ai][bj][m][0], v1 = xa[m2][bj][1] + gv[bj][1] * acc[ai][bj][m][1];
                            u32x4 o; o.x = cvt_pk_bf16(v0[0], v0[1]); o.y = cvt_pk_bf16(v0[2], v0[3]); o.z = cvt_pk_bf16(v1[0], v1[1]); o.w = cvt_pk_bf16(v1[2], v1[3]);
                            *(u32x4*)(xout + row * ldo + col0 + bj * HALF) = o; } }
                }
        }
    }
};
template <class Epi, class Sched, bool ALIGN_EPI = false, bool SP2 = false>
__device__ __forceinline__ void gemm_phase(PG8_LAS unsigned char* lds, const Gemm g, const Sched& S, const Epi& E) {
    int tid_ = threadIdx.x; asm volatile("" : "+v"(tid_));
    const int tid = tid_, wid = __builtin_amdgcn_readfirstlane(tid >> 6), lane = tid & 63, wr = wid >> 2, wc = wid & 3, fr = lane & 15, fq = lane >> 4;
    const int K = g.K, nt = K / BK;
    unsigned voffA[2], voffB[2];
#pragma unroll
    for (int i = 0; i < 2; ++i) { int R, C; stage_rc(tid * 16 + i * 8192, R, C); const int Rb = Epi::PERM ? ((R & ~31) + perm32(R & 31)) : R;
        voffA[i] = (unsigned)(R * K + C) * 2u; voffB[i] = (unsigned)(Rb * K + C) * 2u; }
    const size_t kstep = (size_t)(BK * 2);
    const size_t hstep = (size_t)HALF * K * 2;
    const size_t tstep = 2 * hstep;
    const unsigned ldsw = (unsigned)wid * 1024u;
    const int aoff = lds_byte(wr * 64 + fr, fq * 8), boff = lds_byte(wc * 32 + fr, fq * 8);
#define PG8_SA(b, h) (((b) * 2 + (h)) * HTB)
#define PG8_SB(b, h) ((4 + (b) * 2 + (h)) * HTB)
#define PG8_STAGE(bufoff, gbase, voff) do { _Pragma("unroll") for (int _i = 0; _i < 2; ++_i) \
        __builtin_amdgcn_global_load_lds((const unsigned*)((const char*)(gbase) + (voff)[_i]), (PG8_LAS unsigned*)(lds + (bufoff) + ldsw + _i * 8192), 16, 0, 0); } while (0)
#define PG8_LDA(dst, b, h) do { _Pragma("unroll") for (int m = 0; m < 4; ++m) _Pragma("unroll") for (int k = 0; k < 2; ++k) dst[m][k] = *(const PG8_LAS bf16x8*)(lds + PG8_SA(b, h) + aoff + m * 2048 + k * 1024); } while (0)
#define PG8_LDB(dst, b, h) do { _Pragma("unroll") for (int n = 0; n < 2; ++n) _Pragma("unroll") for (int k = 0; k < 2; ++k) dst[n][k] = *(const PG8_LAS bf16x8*)(lds + PG8_SB(b, h) + boff + n * 2048 + k * 1024); } while (0)
#define PG8_MMA(ai, bj, At, Bt) do { __builtin_amdgcn_s_setprio(1); _Pragma("unroll") for (int m = 0; m < 4; ++m) _Pragma("unroll") for (int n = 0; n < 2; ++n) _Pragma("unroll") for (int k = 0; k < 2; ++k) \
        acc[ai][bj][m][n] = __builtin_amdgcn_mfma_f32_16x16x32_bf16(Bt[n][k], At[m][k], acc[ai][bj][m][n], 0, 0, 0); __builtin_amdgcn_s_setprio(0); } while (0)
#define PG8_WAIT_V(n) asm volatile("s_waitcnt vmcnt(" #n ")" ::: "memory")
#define PG8_WAIT_L(n) asm volatile("s_waitcnt lgkmcnt(" #n ")" ::: "memory")
#define PG8_BAR __builtin_amdgcn_s_barrier()
#define PG8_SCHED __builtin_amdgcn_sched_barrier(0)
    Unit cur, nxt; int ui = 0;
    if (!S.next(0, cur)) return;
    f32x4 acc[2][2][4][2];
#pragma unroll
    for (int a = 0; a < 2; ++a)
#pragma unroll
        for (int b = 0; b < 2; ++b)
#pragma unroll
            for (int m = 0; m < 4; ++m)
#pragma unroll
                for (int n = 0; n < 2; ++n) acc[a][b][m][n] = (f32x4){0.f, 0.f, 0.f, 0.f};
    bf16x8 At[4][2], B0[2][2], B1[2][2];
    const char* cA = (const char*)g.A + (size_t)cur.pm * tstep; const char* cB = (const char*)g.Bt + (size_t)cur.pn * tstep;
    S.a_ready(cur);
    if constexpr (SP2) {
        PG8_STAGE(PG8_SB(0, 0), cB, voffB); PG8_STAGE(PG8_SB(0, 1), cB + hstep, voffB); PG8_STAGE(PG8_SA(0, 0), cA, voffA); PG8_STAGE(PG8_SA(0, 1), cA + hstep, voffA);
        if (wr == 1) PG8_BAR;
        PG8_WAIT_V(2); PG8_BAR;
        PG8_STAGE(PG8_SB(1, 0), cB + kstep, voffB); PG8_STAGE(PG8_SA(1, 0), cA + kstep, voffA); PG8_STAGE(PG8_SB(1, 1), cB + hstep + kstep, voffB);
        PG8_WAIT_V(6); PG8_BAR;
    } else {
        PG8_STAGE(PG8_SB(0, 0), cB, voffB); PG8_STAGE(PG8_SA(0, 0), cA, voffA); PG8_STAGE(PG8_SB(0, 1), cB + hstep, voffB); PG8_STAGE(PG8_SA(0, 1), cA + hstep, voffA);
        if (wr == 1) PG8_BAR;
        PG8_WAIT_V(4); PG8_BAR;
        PG8_STAGE(PG8_SB(1, 0), cB + kstep, voffB); PG8_STAGE(PG8_SA(1, 0), cA + kstep, voffA); PG8_STAGE(PG8_SB(1, 1), cB + hstep + kstep, voffB);
        PG8_WAIT_V(6); PG8_BAR;
    }
    for (;;) {
        const bool has_next = S.next(ui + 1, nxt);
        const char* nA = has_next ? (const char*)g.A + (size_t)nxt.pm * tstep : cA; const char* nB = has_next ? (const char*)g.Bt + (size_t)nxt.pn * tstep : cB;
        for (int t = 0; t < nt; t += 2) {
            const bool last = (t == nt - 2);
            const char* a1 = cA + (size_t)(t + 1) * kstep;
            const char* a2 = last ? nA : cA + (size_t)(t + 2) * kstep; const char* b2 = last ? nB : cB + (size_t)(t + 2) * kstep;
            const char* a3 = a2 + kstep; const char* b3 = b2 + kstep;
            if (last && has_next) S.a_ready(nxt);
            if constexpr (SP2) {
            PG8_LDB(B0, 0, 0); PG8_LDB(B1, 0, 1); PG8_SCHED; PG8_LDA(At, 0, 0); PG8_STAGE(PG8_SA(1, 1), a1 + hstep, voffA);
            PG8_WAIT_V(8); PG8_WAIT_L(0); PG8_BAR; PG8_MMA(0, 0, At, B0); PG8_MMA(0, 1, At, B1); PG8_BAR; PG8_SCHED;
            PG8_LDA(At, 0, 1); PG8_STAGE(PG8_SB(0, 0), b2, voffB); PG8_STAGE(PG8_SB(0, 1), b2 + hstep, voffB); PG8_STAGE(PG8_SA(0, 0), a2, voffA);
            PG8_WAIT_V(8); PG8_WAIT_L(0); PG8_BAR; PG8_MMA(1, 0, At, B0); PG8_MMA(1, 1, At, B1); PG8_BAR; PG8_SCHED;
            PG8_LDB(B0, 1, 0); PG8_LDB(B1, 1, 1); PG8_SCHED; PG8_LDA(At, 1, 0); PG8_STAGE(PG8_SA(0, 1), a2 + hstep, voffA);
            PG8_WAIT_V(8); PG8_WAIT_L(0); PG8_BAR; PG8_MMA(0, 0, At, B0); PG8_MMA(0, 1, At, B1); PG8_BAR; PG8_SCHED;
            PG8_LDA(At, 1, 1); PG8_STAGE(PG8_SB(1, 0), b3, voffB); PG8_STAGE(PG8_SB(1, 1), b3 + hstep, voffB); PG8_STAGE(PG8_SA(1, 0), a3, voffA);
            PG8_WAIT_V(8); PG8_WAIT_L(0); PG8_BAR; PG8_MMA(1, 0, At, B0); PG8_MMA(1, 1, At, B1); PG8_BAR; PG8_SCHED;
            } else {
            PG8_LDB(B0, 0, 0); PG8_SCHED; PG8_LDA(At, 0, 0); PG8_STAGE(PG8_SA(1, 1), a1 + hstep, voffA);
            PG8_WAIT_L(8); PG8_BAR; PG8_WAIT_L(0); PG8_MMA(0, 0, At, B0); PG8_BAR; PG8_SCHED;
            PG8_LDB(B1, 0, 1); PG8_STAGE(PG8_SB(0, 0), b2, voffB);
            PG8_BAR; PG8_WAIT_L(0); PG8_MMA(0, 1, At, B1); PG8_BAR;
            PG8_LDA(At, 0, 1); PG8_STAGE(PG8_SA(0, 0), a2, voffA);
            PG8_BAR; PG8_WAIT_L(0); PG8_MMA(1, 0, At, B0); PG8_BAR; PG8_SCHED;
            PG8_STAGE(PG8_SB(0, 1), b2 + hstep, voffB);
            PG8_WAIT_V(6); PG8_BAR; PG8_MMA(1, 1, At, B1); PG8_BAR;
            PG8_LDB(B0, 1, 0); PG8_SCHED; PG8_LDA(At, 1, 0); PG8_STAGE(PG8_SA(0, 1), a2 + hstep, voffA);
            PG8_WAIT_L(8); PG8_BAR; PG8_WAIT_L(0); PG8_MMA(0, 0, At, B0); PG8_BAR; PG8_SCHED;
            PG8_LDB(B1, 1, 1); PG8_STAGE(PG8_SB(1, 0), b3, voffB);
            PG8_BAR; PG8_WAIT_L(0); PG8_MMA(0, 1, At, B1); PG8_BAR;
            PG8_LDA(At, 1, 1); PG8_STAGE(PG8_SA(1, 0), a3, voffA);
            PG8_BAR; PG8_WAIT_L(0); PG8_MMA(1, 0, At, B0); PG8_BAR; PG8_SCHED;
            PG8_STAGE(PG8_SB(1, 1), b3 + hstep, voffB);
            PG8_WAIT_V(6); PG8_BAR; PG8_MMA(1, 1, At, B1); PG8_BAR;
            }
        }
        if constexpr (ALIGN_EPI) { if (wr == 0) PG8_BAR; }
        if constexpr (!Epi::AFTER_DRAIN) { E(acc, cur, wr, wc, fr, fq); S.done(cur); }
        if (!has_next) break;
#pragma unroll
        for (int a = 0; a < 2; ++a)
#pragma unroll
            for (int b = 0; b < 2; ++b)
#pragma unroll
                for (int m = 0; m < 4; ++m)
#pragma unroll
                    for (int n = 0; n < 2; ++n) acc[a][b][m][n] = (f32x4){0.f, 0.f, 0.f, 0.f};
        cur = nxt; cA = nA; cB = nB; ++ui;
        if constexpr (ALIGN_EPI) { if (wr == 1) PG8_BAR; }
    }
    PG8_WAIT_V(0);
    if constexpr (!ALIGN_EPI) { if (wr == 0) PG8_BAR; }
    PG8_BAR;
    if constexpr (Epi::AFTER_DRAIN) { E.fused(acc, cur, wr, wc, fr, fq, lds, wid, lane); S.done(cur); }
#undef PG8_SA
#undef PG8_SB
#undef PG8_STAGE
#undef PG8_LDA
#undef PG8_LDB
#undef PG8_MMA
#undef PG8_WAIT_V
#undef PG8_WAIT_L
#undef PG8_BAR
#undef PG8_SCHED
}
}
#define PG8_SP2 true
#define PG8_ALIGN true
#define GAS __attribute__((address_space(1)))
#define LAS __attribute__((address_space(3)))
typedef unsigned short bf16;
typedef unsigned v4u __attribute__((ext_vector_type(4)));
typedef float f32x4 __attribute__((ext_vector_type(4)));
typedef short bf16x8 __attribute__((ext_vector_type(8)));
typedef GAS unsigned gu32;
typedef GAS unsigned long long gu64;
#define RLX_AGENT __ATOMIC_RELAXED, __HIP_MEMORY_SCOPE_AGENT
#define LDS_WAIT() asm volatile("s_waitcnt lgkmcnt(0)" ::: "memory")
#define VM_WAIT() asm volatile("s_waitcnt vmcnt(0)" ::: "memory")
__device__ __forceinline__ unsigned long long rt() { return __builtin_amdgcn_s_memrealtime(); }
__device__ __forceinline__ unsigned f2bf(float f) { unsigned u = __builtin_bit_cast(unsigned, f); return (u + 0x7fffu + ((u >> 16) & 1u)) >> 16; }
typedef float f32x2p_ __attribute__((ext_vector_type(2)));
typedef __bf16 bf16x2p_ __attribute__((ext_vector_type(2)));
__device__ __forceinline__ unsigned pk2(float lo, float hi) { f32x2p_ v = {lo, hi}; bf16x2p_ b = __builtin_convertvector(v, bf16x2p_); return __builtin_bit_cast(unsigned, b); }
#define XB_TMO      128
#define XB_XCNT(j)  (256  + 64 * (j))
#define XB_XSUB(j)  (1280 + 64 * (j))
#define XB_XGEN(j)  (2304 + 64 * (j))
#define XB_TOP      3328
#define XB_TOPGEN   3392
#define XCD_BAR_WORDS 3456
#define XB_SPIN_CAP (1u << 18)

__device__ __forceinline__ unsigned xb_ld(unsigned* p)              { return __hip_atomic_load(p, __ATOMIC_RELAXED, __HIP_MEMORY_SCOPE_AGENT); }
__device__ __forceinline__ unsigned xb_add(unsigned* p, unsigned v) { return __hip_atomic_fetch_add(p, v, __ATOMIC_RELAXED, __HIP_MEMORY_SCOPE_AGENT); }
__device__ __forceinline__ unsigned xb_xcc_id() { return (unsigned)__builtin_amdgcn_s_getreg((3 << 11) | 20) & 0xFu; }
#define XB_SPIN(cond, bar) do { unsigned _sp = 0; while (cond) { __builtin_amdgcn_s_sleep(1); \
    if ((++_sp & 255u) == 0u) { if (xb_ld(&(bar)[XB_TMO])) break; if (_sp > XB_SPIN_CAP) { atomicAdd(&(bar)[XB_TMO], 1u); break; } } } } while (0)

struct XcdBarrier {
    unsigned* bar; unsigned x;
    volatile LAS unsigned* st;
};

__device__ __forceinline__ XcdBarrier xcd_barrier_post(unsigned* bar, volatile LAS unsigned* st) {
    XcdBarrier b; b.bar = bar; b.x = xb_xcc_id(); b.st = st;
    if (threadIdx.x == 0) (void)xb_add(&bar[XB_XCNT(b.x)], 1u);
    return b;
}
__device__ __forceinline__ void xcd_barrier_complete(unsigned* bar, unsigned x, unsigned& nloc, unsigned& nx) {
    const unsigned G = gridDim.x * gridDim.y * gridDim.z;
    unsigned sum, cnt, mine, sp = 0u;
    for (;;) {
        sum = 0u; cnt = 0u; mine = 0u;
#pragma unroll
        for (unsigned j = 0; j < 16; ++j) { const unsigned c = xb_ld(&bar[XB_XCNT(j)]); sum += c; cnt += (c > 0u) ? 1u : 0u; mine = (j == x) ? c : mine; }
        if (sum == G) break;
        __builtin_amdgcn_s_sleep(1);
        if ((++sp & 255u) == 0u) { if (xb_ld(&bar[XB_TMO])) break; if (sp > XB_SPIN_CAP) { atomicAdd(&bar[XB_TMO], 1u); break; } }
    }
    nloc = mine > 0u ? mine : 1u; nx = cnt > 0u ? cnt : 1u;
}

__device__ __forceinline__ void xcd_barrier(const XcdBarrier& b) {
    asm volatile("s_waitcnt vmcnt(0)" ::: "memory");
    __syncthreads();
    if (threadIdx.x == 0) {
        unsigned* bar = b.bar;
        __builtin_amdgcn_s_waitcnt(0);
        unsigned nloc = b.st[0], nx = b.st[1];
        if (nloc == 0u) { xcd_barrier_complete(bar, b.x, nloc, nx); b.st[0] = nloc; b.st[1] = nx; }
        const unsigned old = xb_add(&bar[XB_XSUB(b.x)], 1u);
        const unsigned gen = old / nloc;
        if (old + 1u == (gen + 1u) * nloc) {
            __builtin_amdgcn_fence(__ATOMIC_RELEASE, "agent");
            asm volatile("s_waitcnt vmcnt(0)" ::: "memory");
            const unsigned og = xb_add(&bar[XB_TOP], 1u);
            const unsigned tg = og / nx;
            if (og + 1u == (tg + 1u) * nx) xb_add(&bar[XB_TOPGEN], 1u);
            else XB_SPIN(xb_ld(&bar[XB_TOPGEN]) == tg, bar);
            __builtin_amdgcn_fence(__ATOMIC_ACQUIRE, "agent");
            xb_add(&bar[XB_XGEN(b.x)], 1u);
            asm volatile("s_waitcnt vmcnt(0)" ::: "memory");
        } else {
            XB_SPIN(xb_ld(&bar[XB_XGEN(b.x)]) == gen, bar);
            __builtin_amdgcn_fence(__ATOMIC_ACQUIRE, "agent");
            asm volatile("s_waitcnt vmcnt(0)" ::: "memory");
        }
    }
    __syncthreads();
}
constexpr int NWAVES = 8, NTHR = 512;
constexpr int BATCH = 8, SEQ = 4096, D = 1024, M = BATCH * SEQ, DEPTH = 2;
constexpr int NIN = 6656, NA = 4096, NB = 2560;
constexpr int PA_RQ = 0, PA_RK = 512, PA_RV = 1024, PA_RG = 2048, PA_GA = 3072;
constexpr int PB_AQ = 0, PB_AK = 1024, PB_AV = 1280, PB_GB = 1536;
constexpr int NQP = 2048, NEXP = 16384, MODW = 6144;
constexpr float EPS = 1e-6f;
constexpr int XP = 2048;
constexpr size_t MiB = 1u << 20;
constexpr size_t WS_CTL = 0, CTL_ZERO_BYTES = 1 * MiB;
constexpr size_t WS_MOD = 1 * MiB;
constexpr size_t WS_ROPE_R = 2 * MiB;
constexpr size_t WS_ROPE_A = 10 * MiB;
constexpr size_t WS_WIN = 12 * MiB;
constexpr size_t WS_WOUT = 38 * MiB;
constexpr size_t WS_WQ = 42 * MiB;
constexpr size_t WS_K1 = 50 * MiB;
constexpr size_t WS_K2 = WS_K1 + 512 * 1024;
constexpr size_t WS_XN = 52 * MiB;
constexpr size_t WS_MERGED = 116 * MiB;
constexpr size_t WS_PROJ = 180 * MiB;
constexpr size_t WS_QP = WS_PROJ, WS_IDX = WS_PROJ + 128 * MiB, WS_GATE = WS_PROJ + 144 * MiB;
constexpr size_t WS_U8 = WS_MERGED, WS_V8 = WS_MERGED + 16 * MiB, WS_SU = WS_MERGED + 32 * MiB, WS_SV = WS_MERGED + 33 * MiB;
constexpr size_t WS_PREVT = 436 * MiB;
constexpr size_t WS_END = 468 * MiB;
constexpr int CW_BAR = 4096;
constexpr int SCR_BYTES = 147456;
constexpr int LDSCTL_OFF = SCR_BYTES, LDS_BYTES = SCR_BYTES + 1024;

typedef float f32x2v __attribute__((ext_vector_type(2)));
struct Args { const float* in[17]; float* out; unsigned char* ws; int ph_lo, ph_hi, li, pad; };
__device__ const float INV_R[32] = {1.000000000e+00f, 7.498942614e-01f, 5.623413324e-01f, 4.216965139e-01f, 3.162277639e-01f, 2.371373773e-01f, 1.778279394e-01f, 1.333521307e-01f, 1.000000015e-01f, 7.498941571e-02f, 5.623413250e-02f, 4.216965288e-02f, 3.162277490e-02f, 2.371373773e-02f, 1.778279431e-02f, 1.333521493e-02f, 9.999999776e-03f, 7.498941850e-03f, 5.623413250e-03f, 4.216964822e-03f, 3.162277630e-03f, 2.371373586e-03f, 1.778279431e-03f, 1.333521446e-03f, 1.000000047e-03f, 7.498942432e-04f, 5.623413017e-04f, 4.216965172e-04f, 3.162277571e-04f, 2.371373703e-04f, 1.778279402e-04f, 1.333521504e-04f};
__device__ const float INV_A[8] = {1.000000000e+00f, 1.939227432e-01f, 3.760603070e-02f, 7.292664610e-03f, 1.414213562e-03f, 2.742481884e-04f, 5.318296098e-05f, 1.031338616e-05f};

__device__ __forceinline__ float bflo(unsigned w) { return __builtin_bit_cast(float, w << 16); }
__device__ __forceinline__ float bfhi(unsigned w) { return __builtin_bit_cast(float, w & 0xffff0000u); }
__device__ __forceinline__ float bf2f(unsigned short h) { return __builtin_bit_cast(float, (unsigned)h << 16); }
__device__ __forceinline__ void unpack8(const v4u w, float* f) { f[0] = bflo(w.x); f[1] = bfhi(w.x); f[2] = bflo(w.y); f[3] = bfhi(w.y); f[4] = bflo(w.z); f[5] = bfhi(w.z); f[6] = bflo(w.w); f[7] = bfhi(w.w); }
typedef unsigned v2u_ __attribute__((ext_vector_type(2)));
template <int CTRL> __device__ __forceinline__ float dpp_f(float v) { return __builtin_bit_cast(float, __builtin_amdgcn_update_dpp(0, __builtin_bit_cast(int, v), CTRL, 0xf, 0xf, true)); }
__device__ __forceinline__ void swap16_(float v, float& a, float& b) { const v2u_ s = __builtin_amdgcn_permlane16_swap(__builtin_bit_cast(unsigned, v), __builtin_bit_cast(unsigned, v), false, false); const unsigned a_ = s.x, b_ = s.y; a = __builtin_bit_cast(float, a_); b = __builtin_bit_cast(float, b_); }
__device__ __forceinline__ void swap32_(float v, float& a, float& b) { const v2u_ s = __builtin_amdgcn_permlane32_swap(__builtin_bit_cast(unsigned, v), __builtin_bit_cast(unsigned, v), false, false); const unsigned a_ = s.x, b_ = s.y; a = __builtin_bit_cast(float, a_); b = __builtin_bit_cast(float, b_); }
__device__ __forceinline__ float wave_sum(float v) {
    v += dpp_f<0xB1>(v); v += dpp_f<0x4E>(v); v += dpp_f<0x141>(v); v += dpp_f<0x140>(v);
    float a, b; swap16_(v, a, b); v = a + b; swap32_(v, a, b); return a + b;
}
__device__ __forceinline__ float wave_max(float v) {
    v = fmaxf(v, dpp_f<0xB1>(v)); v = fmaxf(v, dpp_f<0x4E>(v)); v = fmaxf(v, dpp_f<0x141>(v)); v = fmaxf(v, dpp_f<0x140>(v));
    float a, b; swap16_(v, a, b); v = fmaxf(a, b); swap32_(v, a, b); return fmaxf(a, b);
}
#define LDS_BARRIER() do { asm volatile("s_waitcnt lgkmcnt(0)" ::: "memory"); __builtin_amdgcn_s_barrier(); asm volatile("" ::: "memory"); } while (0)
__device__ __forceinline__ float sigmoidf_(float x) { return __builtin_amdgcn_rcpf(1.f + __expf(-x)); }
__device__ __forceinline__ float siluf_(float x) { return x * __builtin_amdgcn_rcpf(1.f + __expf(-x)); }
__device__ __forceinline__ float rl_f(float v, int k) { return __builtin_bit_cast(float, __builtin_amdgcn_readlane(__builtin_bit_cast(int, v), k)); }
__device__ __forceinline__ int rl_i(int v, int k) { return __builtin_amdgcn_readlane(v, k); }

__device__ __forceinline__ void p0_transpose_item(const float* W, int K, int N, bf16* WT, int mode, LAS float* scr, int item, int lane) {
    const int nblk = N / 32, kb = item / nblk, nb = item % nblk, k0 = 64 * kb, n0 = 32 * nb;
    int d0 = n0;
    if (mode == 1) { if (n0 >= 3072 && n0 < 4608) d0 = n0 + 1024; else if (n0 >= 4608 && n0 < 5632) d0 = n0 - 1536; }
#pragma unroll 8
    for (int i = 0; i < 32; ++i) { const int kk = 2 * i + (lane >> 5); scr[kk * 33 + (lane & 31)] = W[(size_t)(k0 + kk) * N + n0 + (lane & 31)]; }
    LDS_WAIT(); asm volatile("" ::: "memory");
    const int c = lane & 7;
#pragma unroll
    for (int j = 0; j < 4; ++j) { const int n = (lane >> 3) + 8 * j; const LAS float* s = scr + (8 * c) * 33 + n;
        v4u o; o.x = pk2(s[0 * 33], s[1 * 33]); o.y = pk2(s[2 * 33], s[3 * 33]); o.z = pk2(s[4 * 33], s[5 * 33]); o.w = pk2(s[6 * 33], s[7 * 33]);
        *(GAS v4u*)(WT + (size_t)(d0 + n) * K + k0 + 8 * c) = o; }
    LDS_WAIT(); asm volatile("" ::: "memory");
}
__device__ __forceinline__ void cvt_f32_bf16(const float* src, bf16* dst, size_t n8, size_t g0, size_t gstride) {
    for (size_t i = g0; i < n8; i += gstride) { const f32x4 a = *(const GAS f32x4*)(src + i * 8), b = *(const GAS f32x4*)(src + i * 8 + 4);
        v4u o; o.x = pk2(a.x, a.y); o.y = pk2(a.z, a.w); o.z = pk2(b.x, b.y); o.w = pk2(b.z, b.w); *(GAS v4u*)(dst + i * 8) = o; }
}
__device__ __forceinline__ void phase_prologue(const Args& a, LAS unsigned char* lds, int vcu, int G, int tid) {
    const int lane = tid & 63, wave = __builtin_amdgcn_readfirstlane(tid >> 6);
    unsigned char* ws = a.ws;
    if (vcu < 192) {
        LAS float* cond = (LAS float*)lds; LAS float* red = (LAS float*)(lds + 32768);
        const float* c = a.in[1];
        for (int i = tid; i < BATCH * D; i += NTHR) { const float v = c[i]; cond[i] = v / (1.f + expf(-v)); }
        __syncthreads();
        const int l = vcu / 96, j0 = (vcu % 96) * 64, col = tid & 63, ks = tid >> 6;
        const float* W = a.in[3] + (size_t)l * D * MODW + j0 + col;
        float acc[8];
#pragma unroll
        for (int b = 0; b < 8; ++b) acc[b] = 0.f;
        for (int k = ks * 128; k < ks * 128 + 128; ++k) { const float w = W[(size_t)k * MODW];
#pragma unroll
            for (int b = 0; b < 8; ++b) acc[b] += cond[b * D + k] * w; }
#pragma unroll
        for (int b = 0; b < 8; ++b) red[(ks * 8 + b) * 64 + col] = acc[b];
        __syncthreads();
        { const int b = tid >> 6; float s = 0.f;
#pragma unroll
          for (int k2 = 0; k2 < 8; ++k2) s += red[(k2 * 8 + b) * 64 + col];
          s += a.in[4][l * MODW + j0 + col];
          ((float*)(ws + WS_MOD))[(size_t)(l * 8 + b) * MODW + j0 + col] = s; }
        __syncthreads();
    }
    {
        LAS float* scr = (LAS float*)(lds + 49152 + wave * 8448);
        const int gw = vcu * NWAVES + wave, NGW = G * NWAVES;
        constexpr int I_IN = (D / 64) * (NIN / 32), I_OUT = (D / 64) * (D / 32), I_Q = (D / 64) * (NQP / 32), I_L = I_IN + I_OUT + I_Q;
        for (int it = gw; it < 2 * I_L; it += NGW) {
            const int l = it / I_L; int r = it % I_L;
            if (r < I_IN) { p0_transpose_item(a.in[7] + (size_t)l * D * NIN, D, NIN, (bf16*)(ws + WS_WIN) + (size_t)l * NIN * D, 1, scr, r, lane); continue; } r -= I_IN;
            if (r < I_OUT) { p0_transpose_item(a.in[10] + (size_t)l * D * D, D, D, (bf16*)(ws + WS_WOUT) + (size_t)l * D * D, 0, scr, r, lane); continue; } r -= I_OUT;
            p0_transpose_item(a.in[11] + (size_t)l * D * NQP, D, NQP, (bf16*)(ws + WS_WQ) + (size_t)l * NQP * D, 0, scr, r, lane);
        }
    }
    const size_t gt = (size_t)vcu * NTHR + tid, GT = (size_t)G * NTHR;
    cvt_f32_bf16(a.in[12], (bf16*)(ws + WS_K1), (size_t)2 * 8 * 128 * 128 / 8, gt, GT);
    cvt_f32_bf16(a.in[13], (bf16*)(ws + WS_K2), (size_t)2 * 8 * 128 * 128 / 8, gt, GT);
    {
        const int* pos = (const int*)a.in[2];
        unsigned* tr = (unsigned*)(ws + WS_ROPE_R); unsigned* ta = (unsigned*)(ws + WS_ROPE_A);
        for (size_t idx = gt; idx < (size_t)M * 32; idx += GT) { const int m = (int)(idx >> 5), i = (int)(idx & 31);
            const float ang = (float)pos[m] * INV_R[i]; const double t = (double)ang * 0.15915494309189535; const float r = (float)(t - rint(t));
            tr[idx] = pk2(__builtin_amdgcn_cosf(r), __builtin_amdgcn_sinf(r)); }
        for (size_t idx = gt; idx < (size_t)M * 8; idx += GT) { const int m = (int)(idx >> 3), i = (int)(idx & 7);
            const float ang = (float)pos[m] * INV_A[i]; const double t = (double)ang * 0.15915494309189535; const float r = (float)(t - rint(t));
            ta[idx] = pk2(__builtin_amdgcn_cosf(r), __builtin_amdgcn_sinf(r)); }
    }
}

__device__ __forceinline__ void phase_norm(const float* x, const float* g, const float* mod_sc, const float* mod_sh, bf16* xn, int vcu, int G, int tid) {
    const int lane = tid & 63, wave = __builtin_amdgcn_readfirstlane(tid >> 6);
    const int gw = vcu * NWAVES + wave, NGW = G * NWAVES;
    constexpr int RI = 4;
    f32x4 gg[4];
#pragma unroll
    for (int j = 0; j < 4; ++j) gg[j] = ((const GAS f32x4*)g)[lane + 64 * j];
    for (int m0 = gw; m0 < M; m0 += NGW * RI) {
        f32x4 v[RI][4]; float s[RI];
#pragma unroll
        for (int r = 0; r < RI; ++r) { const int m = m0 + r * NGW; const GAS f32x4* xr = (const GAS f32x4*)(x + (size_t)(m < M ? m : gw) * D) + lane;
#pragma unroll
            for (int j = 0; j < 4; ++j) v[r][j] = xr[64 * j]; }
#pragma unroll
        for (int r = 0; r < RI; ++r) { float a = 0.f;
#pragma unroll
            for (int j = 0; j < 4; ++j) a += (v[r][j].x * v[r][j].x + v[r][j].y * v[r][j].y) + (v[r][j].z * v[r][j].z + v[r][j].w * v[r][j].w);
            s[r] = a; }
#pragma unroll
        for (int r = 0; r < RI; ++r) s[r] = wave_sum(s[r]);
#pragma unroll
        for (int r = 0; r < RI; ++r) { const int m = m0 + r * NGW; const int mc = m < M ? m : gw; const int b = mc >> 12; const float rstd = rsqrtf(s[r] * (1.f / D) + EPS);
            const float* sc = mod_sc + (size_t)b * MODW; const float* sh = mod_sh + (size_t)b * MODW;
            f32x4 cc[4], hh[4];
#pragma unroll
            for (int j = 0; j < 4; ++j) { cc[j] = ((const GAS f32x4*)sc)[lane + 64 * j]; hh[j] = ((const GAS f32x4*)sh)[lane + 64 * j]; }
            asm volatile("" ::: "memory");
            if (m < M) { GAS unsigned long long* o8 = (GAS unsigned long long*)(xn + (size_t)m * D) + lane;
#pragma unroll
                for (int j = 0; j < 4; ++j) { const f32x4 y = (v[r][j] * rstd * gg[j]) * (cc[j] + 1.0f) + hh[j];
                    o8[64 * j] = (unsigned long long)pk2(y.x, y.y) | ((unsigned long long)pk2(y.z, y.w) << 32); } } }
    }
}
__device__ __forceinline__ void phase_norm_b(const bf16* x, const float* g, const float* mod_sc, const float* mod_sh, bf16* xn, int vcu, int G, int tid) {
    const int lane = tid & 63, wave = __builtin_amdgcn_readfirstlane(tid >> 6);
    const int gw = vcu * NWAVES + wave, NGW = G * NWAVES;
    constexpr int RI = 4;
    f32x4 gg[2][2];
#pragma unroll
    for (int j = 0; j < 2; ++j)
#pragma unroll
        for (int q = 0; q < 2; ++q) gg[j][q] = *(const GAS f32x4*)(g + 8 * (lane + 64 * j) + 4 * q);
    for (int m0 = gw; m0 < M; m0 += NGW * RI) {
        v4u v[RI][2]; float s[RI];
#pragma unroll
        for (int r = 0; r < RI; ++r) { const int m = m0 + r * NGW; const GAS v4u* xr = (const GAS v4u*)(x + (size_t)(m < M ? m : gw) * XP) + lane; v[r][0] = xr[0]; v[r][1] = xr[64]; }
#pragma unroll
        for (int r = 0; r < RI; ++r) { float f[16]; unpack8(v[r][0], f); unpack8(v[r][1], f + 8); float a = 0.f;
#pragma unroll
            for (int j = 0; j < 16; j += 4) a += (f[j] * f[j] + f[j + 1] * f[j + 1]) + (f[j + 2] * f[j + 2] + f[j + 3] * f[j + 3]);
            s[r] = a; }
#pragma unroll
        for (int r = 0; r < RI; ++r) s[r] = wave_sum(s[r]);
#pragma unroll
        for (int r = 0; r < RI; ++r) { const int m = m0 + r * NGW; const int mc = m < M ? m : gw; const int b = mc >> 12; const float rstd = rsqrtf(s[r] * (1.f / D) + EPS);
            const float* sc = mod_sc + (size_t)b * MODW; const float* sh = mod_sh + (size_t)b * MODW;
            f32x4 cc[2][2], hh[2][2];
#pragma unroll
            for (int j = 0; j < 2; ++j)
#pragma unroll
                for (int q = 0; q < 2; ++q) { cc[j][q] = *(const GAS f32x4*)(sc + 8 * (lane + 64 * j) + 4 * q); hh[j][q] = *(const GAS f32x4*)(sh + 8 * (lane + 64 * j) + 4 * q); }
            asm volatile("" ::: "memory");
            if (m < M) {
#pragma unroll
                for (int j = 0; j < 2; ++j) { const int c0 = 8 * (lane + 64 * j); float f[8]; unpack8(v[r][j], f); unsigned pk[4];
#pragma unroll
                    for (int q = 0; q < 2; ++q) { const f32x4 xv = (f32x4){f[4 * q], f[4 * q + 1], f[4 * q + 2], f[4 * q + 3]};
                        const f32x4 y = (xv * rstd * gg[j][q]) * (cc[j][q] + 1.0f) + hh[j][q]; pk[2 * q] = pk2(y.x, y.y); pk[2 * q + 1] = pk2(y.z, y.w); }
                    *(GAS v4u*)(xn + (size_t)m * D + c0) = (v4u){pk[0], pk[1], pk[2], pk[3]}; } } }
    }
}

__device__ __forceinline__ float ret_log2g(int h) { return log2f(1.f - exp2f(-5.f - (float)h)); }
typedef float f32x16v_ __attribute__((ext_vector_type(16)));
typedef short bf16x8v_ __attribute__((ext_vector_type(8)));
typedef __bf16 bf16x2_t_ __attribute__((ext_vector_type(2)));
__device__ __forceinline__ unsigned cvtpk_(float lo, float hi) { f32x2v v = {lo, hi}; bf16x2_t_ b = __builtin_convertvector(v, bf16x2_t_); return __builtin_bit_cast(unsigned, b); }
__device__ __forceinline__ int mrow(int r, int h5) { return (r & 3) + 8 * (r >> 2) + 4 * h5; }
__device__ __forceinline__ void phase_swa_mfma(const bf16* projB, const unsigned* ropeA, const float* sinks, bf16* merged, LAS unsigned char* lds, int vcu, int G, int tid) {
    const int lane = tid & 63, wave = __builtin_amdgcn_readfirstlane(tid >> 6), h5 = lane >> 5, l31 = lane & 31;
    LAS unsigned short* Ks = (LAS unsigned short*)lds;
    LAS unsigned short* Vt = (LAS unsigned short*)(lds + 36864);
    const float L2E = 1.4426950408889634f;
    const int frow = tid >> 1, fhalf = tid & 1;
    v4u kw[4], vw[4], kcs[2];
#define SWA_LOAD(uu) do { const int kvh_ = (uu) & 3, n_ = ((uu) >> 2) & 31, b_ = (uu) >> 7; int tok_ = b_ * SEQ + n_ * 128 - 128 + frow; tok_ = (n_ > 0 || frow >= 128) ? tok_ : b_ * SEQ + frow; \
        const bf16* kp_ = projB + (size_t)tok_ * NB + PB_AK + kvh_ * 64 + fhalf * 32; const bf16* vp_ = projB + (size_t)tok_ * NB + PB_AV + kvh_ * 64 + fhalf * 32; \
        _Pragma("unroll") for (int i = 0; i < 4; ++i) { kw[i] = *(const GAS v4u*)(kp_ + 8 * i); vw[i] = *(const GAS v4u*)(vp_ + 8 * i); } \
        kcs[0] = *(const GAS v4u*)(ropeA + (size_t)tok_ * 8); kcs[1] = *(const GAS v4u*)(ropeA + (size_t)tok_ * 8 + 4); } while (0)
    if (vcu < 1024) SWA_LOAD(vcu);
    for (int u = vcu; u < 1024; u += G) {
        const int kvh = u & 3, n = (u >> 2) & 31, b = u >> 7; const int tok0 = b * SEQ + n * 128;
        const int a = kvh * 4 + (wave >> 1);
        v4u qraw[2][4]; v4u qcs[2][2];
#pragma unroll
        for (int i = 0; i < 2; ++i) { const size_t token = (size_t)tok0 + (wave & 1) * 64 + 32 * i + l31; const bf16* qp = projB + token * NB + PB_AQ + a * 64 + 8 * h5;
#pragma unroll
            for (int s_ = 0; s_ < 4; ++s_) qraw[i][s_] = *(const GAS v4u*)(qp + 16 * s_);
            qcs[i][0] = *(const GAS v4u*)(ropeA + token * 8); qcs[i][1] = *(const GAS v4u*)(ropeA + token * 8 + 4); }
        {
            const int row = frow, half = fhalf; const bool valid = (n > 0) || (row >= 128);
            if (half == 0) { float t1[8], t2[8]; unpack8(kw[0], t1); unpack8(kw[1], t2); float o1[8], o2[8];
#pragma unroll
                for (int j = 0; j < 8; ++j) { const unsigned cw_ = kcs[j >> 2][j & 3]; const float cc = bflo(cw_), ss = bfhi(cw_); o1[j] = t1[j] * cc - t2[j] * ss; o2[j] = t2[j] * cc + t1[j] * ss; }
                kw[0] = (v4u){cvtpk_(o1[0], o1[1]), cvtpk_(o1[2], o1[3]), cvtpk_(o1[4], o1[5]), cvtpk_(o1[6], o1[7])};
                kw[1] = (v4u){cvtpk_(o2[0], o2[1]), cvtpk_(o2[2], o2[3]), cvtpk_(o2[4], o2[5]), cvtpk_(o2[6], o2[7])}; }
            const unsigned vm_ = valid ? 0xffffffffu : 0u;
#pragma unroll
            for (int i = 0; i < 4; ++i) *(LAS v4u*)(Ks + row * 72 + half * 32 + 8 * i) = (v4u){kw[i].x & vm_, kw[i].y & vm_, kw[i].z & vm_, kw[i].w & vm_};
#pragma unroll
            for (int i = 0; i < 4; ++i)
#pragma unroll
                for (int j = 0; j < 4; ++j) { const unsigned w = vw[i][j] & vm_; Vt[(half * 32 + 8 * i + 2 * j) * 260 + row] = (unsigned short)(w & 0xffffu); Vt[(half * 32 + 8 * i + 2 * j + 1) * 260 + row] = (unsigned short)(w >> 16); }
        }
        LDS_BARRIER();
        if (u + G < 1024) SWA_LOAD(u + G);
        const float sink = sinks[a];
#pragma unroll
        for (int i = 0; i < 2; ++i) {
            const int q0 = (wave & 1) * 64 + 32 * i, kt0 = q0 >> 5; const size_t token = (size_t)tok0 + q0 + l31;
            bf16x8v_ qf[4];
            { v4u qw[4];
#pragma unroll
              for (int s_ = 0; s_ < 4; ++s_) qw[s_] = qraw[i][s_];
              v4u pw;
#pragma unroll
              for (int j = 0; j < 4; ++j) pw[j] = (unsigned)__shfl_xor((int)qw[0][j], 32);
              float own[8], oth[8]; unpack8(qw[0], own); unpack8(pw, oth); float o[8];
#pragma unroll
              for (int j = 0; j < 8; ++j) { const unsigned cw_ = qcs[i][j >> 2][j & 3]; const f32x2v c = (f32x2v){bflo(cw_), bfhi(cw_)}; const float ow_ = own[j], ot_ = oth[j]; const float t1 = h5 ? ot_ : ow_, t2 = h5 ? ow_ : ot_; o[j] = (h5 ? (t2 * c.x + t1 * c.y) : (t1 * c.x - t2 * c.y)) * 0.125f; }
              qw[0] = (v4u){cvtpk_(o[0], o[1]), cvtpk_(o[2], o[3]), cvtpk_(o[4], o[5]), cvtpk_(o[6], o[7])};
#pragma unroll
              for (int s_ = 1; s_ < 4; ++s_) { float f[8]; unpack8(qw[s_], f); qw[s_] = (v4u){cvtpk_(f[0] * 0.125f, f[1] * 0.125f), cvtpk_(f[2] * 0.125f, f[3] * 0.125f), cvtpk_(f[4] * 0.125f, f[5] * 0.125f), cvtpk_(f[6] * 0.125f, f[7] * 0.125f)}; }
#pragma unroll
              for (int s_ = 0; s_ < 4; ++s_) qf[s_] = __builtin_bit_cast(bf16x8v_, qw[s_]); }
            f32x16v_ sacc[5];
#pragma unroll
            for (int jt = 0; jt < 5; ++jt) {
#pragma unroll
                for (int r = 0; r < 16; ++r) sacc[jt][r] = 0.f;
#pragma unroll
                for (int s_ = 0; s_ < 4; ++s_) { const bf16x8v_ kf = *(const LAS bf16x8v_*)(Ks + (32 * (kt0 + jt) + l31) * 72 + 16 * s_ + 8 * h5); sacc[jt] = __builtin_amdgcn_mfma_f32_32x32x16_bf16(kf, qf[s_], sacc[jt], 0, 0, 0); }
            }
            v4u gwv[4];
#pragma unroll
            for (int i2 = 0; i2 < 4; ++i2) gwv[i2] = *(const GAS v4u*)(projB + token * NB + PB_GB + a * 64 + 32 * h5 + 8 * i2);
            float mx = -1e30f;
#pragma unroll
            for (int jt = 0; jt < 5; ++jt) { const bool tile_ok = (n > 0) || (kt0 + jt >= 4);
#pragma unroll
                for (int r = 0; r < 16; ++r) { const int kl = mrow(r, h5); bool ok = tile_ok; if (jt == 0) ok = ok && (kl > l31); if (jt == 4) ok = ok && (kl <= l31);
                    const float sv_ = ok ? sacc[jt][r] : -1e30f; sacc[jt][r] = sv_; mx = fmaxf(mx, sv_); } }
            mx = fmaxf(mx, __shfl_xor(mx, 32)); mx = fmaxf(mx, sink);
            float sm = 0.f; const float mxl = -mx * L2E;
#pragma unroll
            for (int jt = 0; jt < 5; ++jt)
#pragma unroll
                for (int r = 0; r < 16; ++r) { const float p = __builtin_amdgcn_exp2f(fmaf(sacc[jt][r], L2E, mxl)); sacc[jt][r] = p; sm += p; }
            sm += __shfl_xor(sm, 32);
            const float inv = __builtin_amdgcn_rcpf(sm + __builtin_amdgcn_exp2f(fmaf(sink, L2E, mxl)));
            f32x16v_ oacc[2];
#pragma unroll
            for (int dt = 0; dt < 2; ++dt)
#pragma unroll
                for (int r = 0; r < 16; ++r) oacc[dt][r] = 0.f;
#pragma unroll
            for (int jt = 0; jt < 5; ++jt)
#pragma unroll
                for (int s2 = 0; s2 < 2; ++s2) {
                    const v4u pw = (v4u){cvtpk_(sacc[jt][8 * s2 + 0], sacc[jt][8 * s2 + 1]), cvtpk_(sacc[jt][8 * s2 + 2], sacc[jt][8 * s2 + 3]), cvtpk_(sacc[jt][8 * s2 + 4], sacc[jt][8 * s2 + 5]), cvtpk_(sacc[jt][8 * s2 + 6], sacc[jt][8 * s2 + 7])};
                    const bf16x8v_ pf = __builtin_bit_cast(bf16x8v_, pw);
#pragma unroll
                    for (int dt = 0; dt < 2; ++dt) { const LAS unsigned short* vp_ = Vt + (32 * dt + l31) * 260 + 32 * (kt0 + jt) + 16 * s2 + 4 * h5;
                        const unsigned long long lo = *(const LAS unsigned long long*)vp_, hi = *(const LAS unsigned long long*)(vp_ + 8);
                        const v4u aw = (v4u){(unsigned)lo, (unsigned)(lo >> 32), (unsigned)hi, (unsigned)(hi >> 32)};
                        oacc[dt] = __builtin_amdgcn_mfma_f32_32x32x16_bf16(__builtin_bit_cast(bf16x8v_, aw), pf, oacc[dt], 0, 0, 0); }
                }
            { LAS float* Ow = (LAS float*)(lds + 70144) + wave * (32 * 68);
#pragma unroll
              for (int dt = 0; dt < 2; ++dt)
#pragma unroll
                  for (int g_ = 0; g_ < 4; ++g_) *(LAS f32x4*)(Ow + l31 * 68 + 32 * dt + 8 * g_ + 4 * h5) = (f32x4){oacc[dt][4 * g_ + 0] * inv, oacc[dt][4 * g_ + 1] * inv, oacc[dt][4 * g_ + 2] * inv, oacc[dt][4 * g_ + 3] * inv};
              asm volatile("s_waitcnt lgkmcnt(0)" ::: "memory");
              bf16* mp = merged + token * D + a * 64 + 32 * h5;
#pragma unroll
              for (int i2 = 0; i2 < 4; ++i2) { const f32x4 oa = *(const LAS f32x4*)(Ow + l31 * 68 + 32 * h5 + 8 * i2), ob = *(const LAS f32x4*)(Ow + l31 * 68 + 32 * h5 + 8 * i2 + 4);
                  float gf[8]; unpack8(gwv[i2], gf);
                  *(GAS v4u*)(mp + 8 * i2) = (v4u){cvtpk_(oa[0] * sigmoidf_(gf[0]), oa[1] * sigmoidf_(gf[1])), cvtpk_(oa[2] * sigmoidf_(gf[2]), oa[3] * sigmoidf_(gf[3])),
                                                   cvtpk_(ob[0] * sigmoidf_(gf[4]), ob[1] * sigmoidf_(gf[5])), cvtpk_(ob[2] * sigmoidf_(gf[6]), ob[3] * sigmoidf_(gf[7]))}; }
              asm volatile("s_waitcnt lgkmcnt(0)" ::: "memory"); }
        }
        LDS_BARRIER();
    }
#undef SWA_LOAD
}


typedef short v4i16_ __attribute__((ext_vector_type(4)));
__device__ __forceinline__ v4i16_ lds_tr4(const LAS unsigned short* p) { return __builtin_amdgcn_ds_read_tr16_b64_v4i16((LAS v4i16_*)p); }
__device__ __forceinline__ void phase_ret_kv_mfma(const bf16* projA, const unsigned* ropeR, float* KVT, LAS unsigned char* lds, int vcu, int G, int tid) {
    const int lane = tid & 63, wave = __builtin_amdgcn_readfirstlane(tid >> 6), h5 = lane >> 5, l31 = lane & 31;
    LAS unsigned short* Kr = (LAS unsigned short*)lds;
    LAS unsigned short* Vr = (LAS unsigned short*)(lds + 24576);
    const int m = tid >> 2, seg = tid & 3, i0 = seg * 8;
    v4u wa, wb, vw[4], cs[2];
#define R1_LOAD(uu) do { const int n_ = (uu) & 31, h_ = ((uu) >> 5) & 7, b_ = (uu) >> 8; const size_t tok_ = (size_t)b_ * SEQ + n_ * 128 + m; \
        const bf16* kp_ = projA + tok_ * NA + PA_RK + h_ * 64; wa = *(const GAS v4u*)(kp_ + i0); wb = *(const GAS v4u*)(kp_ + i0 + 32); \
        cs[0] = *(const GAS v4u*)(ropeR + tok_ * 32 + i0); cs[1] = *(const GAS v4u*)(ropeR + tok_ * 32 + i0 + 4); \
        const bf16* vp_ = projA + tok_ * NA + PA_RV + h_ * 128 + seg * 32; _Pragma("unroll") for (int i = 0; i < 4; ++i) vw[i] = *(const GAS v4u*)(vp_ + 8 * i); } while (0)
    if (vcu < 2048) R1_LOAD(vcu);
    const int trq = (lane & 15) >> 2, trp = lane & 3, trg = (lane >> 4) & 1;
    for (int u = vcu; u < 2048; u += G) {
        const int h = (u >> 5) & 7; const float l2g = ret_log2g(h);
        { float t1[8], t2[8]; unpack8(wa, t1); unpack8(wb, t2); const float w = 0.125f * __builtin_amdgcn_exp2f((float)(127 - m) * l2g); float o1[8], o2[8];
#pragma unroll
          for (int j = 0; j < 8; ++j) { const unsigned cw_ = cs[j >> 2][j & 3]; const f32x2v c = (f32x2v){bflo(cw_), bfhi(cw_)}; o1[j] = (t1[j] * c.x - t2[j] * c.y) * w; o2[j] = (t2[j] * c.x + t1[j] * c.y) * w; }
          *(LAS v4u*)(Kr + m * 96 + i0) = (v4u){cvtpk_(o1[0], o1[1]), cvtpk_(o1[2], o1[3]), cvtpk_(o1[4], o1[5]), cvtpk_(o1[6], o1[7])};
          *(LAS v4u*)(Kr + m * 96 + i0 + 32) = (v4u){cvtpk_(o2[0], o2[1]), cvtpk_(o2[2], o2[3]), cvtpk_(o2[4], o2[5]), cvtpk_(o2[6], o2[7])};
#pragma unroll
          for (int i = 0; i < 4; ++i) *(LAS v4u*)(Vr + m * 160 + seg * 32 + 8 * i) = vw[i]; }
        LDS_BARRIER();
        if (u + G < 2048) R1_LOAD(u + G);
        const int dvt = wave >> 1, dkt = wave & 1;
        f32x16v_ acc;
#pragma unroll
        for (int r = 0; r < 16; ++r) acc[r] = 0.f;
        const LAS unsigned short* va = Vr + (8 * h5 + trq) * 160 + 32 * dvt + 16 * trg + 4 * trp;
        const LAS unsigned short* ka = Kr + (8 * h5 + trq) * 96 + 32 * dkt + 16 * trg + 4 * trp;
#pragma unroll
        for (int s_ = 0; s_ < 8; ++s_) { const v4i16_ a0 = lds_tr4(va + 16 * s_ * 160), a1 = lds_tr4(va + (16 * s_ + 4) * 160), b0 = lds_tr4(ka + 16 * s_ * 96), b1 = lds_tr4(ka + (16 * s_ + 4) * 96);
            const bf16x8v_ af = (bf16x8v_){a0[0], a0[1], a0[2], a0[3], a1[0], a1[1], a1[2], a1[3]}, bfr = (bf16x8v_){b0[0], b0[1], b0[2], b0[3], b1[0], b1[1], b1[2], b1[3]};
            acc = __builtin_amdgcn_mfma_f32_32x32x16_bf16(af, bfr, acc, 0, 0, 0); }
        bf16* op = (bf16*)KVT + (size_t)u * 8192 + 32 * dkt + l31;
#pragma unroll
        for (int r = 0; r < 16; ++r) { const float v_ = acc[r]; const float nb_ = dpp_f<0xB1>(v_); if ((lane & 1) == 0) *(GAS unsigned*)(op + (size_t)(32 * dvt + mrow(r, h5)) * 64) = pk2(v_, nb_); }
        LDS_BARRIER();
    }
#undef R1_LOAD
}
__device__ __forceinline__ void phase_ret_scan2(const float* KVT, bf16* PREVT, int vcu, int G, int tid) {
    const size_t gt = (size_t)vcu * NTHR + tid, GT_ = (size_t)G * NTHR;
    const unsigned* KVb = (const unsigned*)KVT;
    for (size_t idx = gt; idx < (size_t)64 * 4096; idx += GT_) { const int bh = (int)(idx >> 12), pr = (int)(idx & 4095), h = bh & 7;
        const float cd = exp2f(128.f * ret_log2g(h)); f32x2v st = (f32x2v){0.f, 0.f}; unsigned kv[32];
#pragma unroll
        for (int n = 0; n < 32; ++n) kv[n] = KVb[(size_t)(bh * 32 + n) * 4096 + pr];
#pragma unroll
        for (int n = 0; n < 32; ++n) { *(GAS unsigned*)(PREVT + (size_t)(bh * 32 + n) * 8192 + 2 * pr) = pk2(st.x, st.y); st = st * cd + (f32x2v){bflo(kv[n]), bfhi(kv[n])}; } }
}
__device__ __forceinline__ void phase_ret_out_mfma(const bf16* projA, const unsigned* ropeR, const bf16* PREVT, const float* gn_g, bf16* merged, LAS unsigned char* lds, int vcu, int G, int tid) {
    const int lane = tid & 63, wave = __builtin_amdgcn_readfirstlane(tid >> 6), h5 = lane >> 5, l31 = lane & 31;
    LAS unsigned short* Ks = (LAS unsigned short*)lds;
    LAS unsigned short* Vt = (LAS unsigned short*)(lds + 18432);
    LAS unsigned short* St = (LAS unsigned short*)(lds + 52224);
    LAS float* Xs = (LAS float*)(lds + 70656);
    const int m = tid >> 2, seg = tid & 3, i0 = seg * 8;
    v4u wa, wb, vw[4], pvw[2], fcs[2];
#define R3_LOAD(uu) do { const int n_ = (uu) & 31, h_ = ((uu) >> 5) & 7, b_ = (uu) >> 8; const size_t tok_ = (size_t)b_ * SEQ + n_ * 128 + m; \
        const bf16* kp_ = projA + tok_ * NA + PA_RK + h_ * 64; wa = *(const GAS v4u*)(kp_ + i0); wb = *(const GAS v4u*)(kp_ + i0 + 32); \
        fcs[0] = *(const GAS v4u*)(ropeR + tok_ * 32 + i0); fcs[1] = *(const GAS v4u*)(ropeR + tok_ * 32 + i0 + 4); \
        const bf16* vp_ = projA + tok_ * NA + PA_RV + h_ * 128 + seg * 32; _Pragma("unroll") for (int i = 0; i < 4; ++i) vw[i] = *(const GAS v4u*)(vp_ + 8 * i); \
        _Pragma("unroll") for (int i = 0; i < 2; ++i) { const int idx_ = tid + NTHR * i; pvw[i] = *(const GAS v4u*)(PREVT + (size_t)(uu) * 8192 + (idx_ >> 3) * 64 + 8 * (idx_ & 7)); } } while (0)
    if (vcu < 2048) R3_LOAD(vcu);
    for (int u = vcu; u < 2048; u += G) {
        const int n = u & 31, h = (u >> 5) & 7, b = u >> 8; const int tok0 = b * SEQ + n * 128; const float l2g = ret_log2g(h);
        const int ct = wave & 3, dvh = wave >> 2; const size_t token = (size_t)tok0 + 32 * ct + l31;
        v4u qraw[4]; v4u qcs[2][2];
        { const bf16* qp = projA + token * NA + PA_RQ + h * 64 + 8 * h5;
#pragma unroll
          for (int s_ = 0; s_ < 4; ++s_) qraw[s_] = *(const GAS v4u*)(qp + 16 * s_);
#pragma unroll
          for (int s_ = 0; s_ < 2; ++s_) { qcs[s_][0] = *(const GAS v4u*)(ropeR + token * 32 + 16 * s_ + 8 * h5); qcs[s_][1] = *(const GAS v4u*)(ropeR + token * 32 + 16 * s_ + 8 * h5 + 4); } }
        { float t1[8], t2[8]; unpack8(wa, t1); unpack8(wb, t2); float o1[8], o2[8];
#pragma unroll
          for (int j = 0; j < 8; ++j) { const unsigned cw_ = fcs[j >> 2][j & 3]; const f32x2v c = (f32x2v){bflo(cw_), bfhi(cw_)}; o1[j] = (t1[j] * c.x - t2[j] * c.y) * 0.125f; o2[j] = (t2[j] * c.x + t1[j] * c.y) * 0.125f; }
          *(LAS v4u*)(Ks + m * 72 + i0) = (v4u){cvtpk_(o1[0], o1[1]), cvtpk_(o1[2], o1[3]), cvtpk_(o1[4], o1[5]), cvtpk_(o1[6], o1[7])};
          *(LAS v4u*)(Ks + m * 72 + i0 + 32) = (v4u){cvtpk_(o2[0], o2[1]), cvtpk_(o2[2], o2[3]), cvtpk_(o2[4], o2[5]), cvtpk_(o2[6], o2[7])};
#pragma unroll
          for (int i = 0; i < 4; ++i)
#pragma unroll
              for (int j = 0; j < 4; ++j) { const unsigned wv_ = vw[i][j]; Vt[(seg * 32 + 8 * i + 2 * j) * 132 + m] = (unsigned short)(wv_ & 0xffffu); Vt[(seg * 32 + 8 * i + 2 * j + 1) * 132 + m] = (unsigned short)(wv_ >> 16); }
#pragma unroll
          for (int i = 0; i < 2; ++i) { const int idx = tid + NTHR * i, row = idx >> 3, c8 = idx & 7; *(LAS v4u*)(St + row * 72 + 8 * c8) = pvw[i]; } }
        LDS_BARRIER();
        if (u + G < 2048) R3_LOAD(u + G);
        bf16x8v_ qf[4];
        {
#pragma unroll
          for (int s_ = 0; s_ < 2; ++s_) { float t1[8], t2[8]; unpack8(qraw[s_], t1); unpack8(qraw[s_ + 2], t2); float o1[8], o2[8];
#pragma unroll
              for (int j = 0; j < 8; ++j) { const unsigned cw_ = qcs[s_][j >> 2][j & 3]; const f32x2v c = (f32x2v){bflo(cw_), bfhi(cw_)}; o1[j] = t1[j] * c.x - t2[j] * c.y; o2[j] = t2[j] * c.x + t1[j] * c.y; }
              qf[s_] = __builtin_bit_cast(bf16x8v_, (v4u){cvtpk_(o1[0], o1[1]), cvtpk_(o1[2], o1[3]), cvtpk_(o1[4], o1[5]), cvtpk_(o1[6], o1[7])});
              qf[s_ + 2] = __builtin_bit_cast(bf16x8v_, (v4u){cvtpk_(o2[0], o2[1]), cvtpk_(o2[2], o2[3]), cvtpk_(o2[4], o2[5]), cvtpk_(o2[6], o2[7])}); } }
        float fa[4], fb[4];
#pragma unroll
        for (int i = 0; i < 4; ++i) { fa[i] = __builtin_amdgcn_exp2f(-(float)(i + 4 * h5) * l2g); fb[i] = __builtin_amdgcn_exp2f(-(float)(8 * i) * l2g); }
        const float Ec = __builtin_amdgcn_exp2f((float)l31 * l2g);
        f32x16v_ oacc[2];
#pragma unroll
        for (int dvt = 0; dvt < 2; ++dvt)
#pragma unroll
            for (int r = 0; r < 16; ++r) oacc[dvt][r] = 0.f;
#pragma unroll 1
        for (int mt = 0; mt <= ct; ++mt) {
            f32x16v_ sacc;
#pragma unroll
            for (int r = 0; r < 16; ++r) sacc[r] = 0.f;
#pragma unroll
            for (int s_ = 0; s_ < 4; ++s_) { const bf16x8v_ kf = *(const LAS bf16x8v_*)(Ks + (32 * mt + l31) * 72 + 16 * s_ + 8 * h5); sacc = __builtin_amdgcn_mfma_f32_32x32x16_bf16(kf, qf[s_], sacc, 0, 0, 0); }
            const float TE = __builtin_amdgcn_exp2f((float)(32 * (ct - mt)) * l2g) * Ec; const bool diag = (mt == ct);
#pragma unroll
            for (int r = 0; r < 16; ++r) { float v = sacc[r] * (TE * fb[r >> 2]) * fa[r & 3]; if (diag && mrow(r, h5) > l31) v = 0.f; sacc[r] = v; }
#pragma unroll
            for (int s2 = 0; s2 < 2; ++s2) {
                const bf16x8v_ pf = __builtin_bit_cast(bf16x8v_, (v4u){cvtpk_(sacc[8 * s2 + 0], sacc[8 * s2 + 1]), cvtpk_(sacc[8 * s2 + 2], sacc[8 * s2 + 3]), cvtpk_(sacc[8 * s2 + 4], sacc[8 * s2 + 5]), cvtpk_(sacc[8 * s2 + 6], sacc[8 * s2 + 7])});
#pragma unroll
                for (int dvt = 0; dvt < 2; ++dvt) { const LAS unsigned short* vp_ = Vt + (64 * dvh + 32 * dvt + l31) * 132 + 32 * mt + 16 * s2 + 4 * h5;
                    const unsigned long long lo = *(const LAS unsigned long long*)vp_, hi = *(const LAS unsigned long long*)(vp_ + 8);
                    oacc[dvt] = __builtin_amdgcn_mfma_f32_32x32x16_bf16(__builtin_bit_cast(bf16x8v_, (v4u){(unsigned)lo, (unsigned)(lo >> 32), (unsigned)hi, (unsigned)(hi >> 32)}), pf, oacc[dvt], 0, 0, 0); }
            }
        }
        const int etok = tid >> 2, eq = tid & 3;
        v4u rgv[4], gav[4], mwv[4]; f32x4 gnv[4][2];
        { const size_t et = (size_t)tok0 + etok; const int ch0 = h * 128 + 32 * eq;
#pragma unroll
          for (int i = 0; i < 4; ++i) { rgv[i] = *(const GAS v4u*)(projA + et * NA + PA_RG + ch0 + 8 * i); gav[i] = *(const GAS v4u*)(projA + et * NA + PA_GA + ch0 + 8 * i); mwv[i] = *(const GAS v4u*)(merged + et * D + ch0 + 8 * i);
              gnv[i][0] = *(const GAS f32x4*)(gn_g + ch0 + 8 * i); gnv[i][1] = *(const GAS f32x4*)(gn_g + ch0 + 8 * i + 4); } }
        {
            const float qw_ = __builtin_amdgcn_exp2f((float)(32 * ct + l31 + 1) * l2g);
#pragma unroll
            for (int dvt = 0; dvt < 2; ++dvt) { f32x16v_ cacc;
#pragma unroll
                for (int r = 0; r < 16; ++r) cacc[r] = 0.f;
#pragma unroll
                for (int s_ = 0; s_ < 4; ++s_) { const bf16x8v_ sf = *(const LAS bf16x8v_*)(St + (64 * dvh + 32 * dvt + l31) * 72 + 16 * s_ + 8 * h5); cacc = __builtin_amdgcn_mfma_f32_32x32x16_bf16(sf, qf[s_], cacc, 0, 0, 0); }
#pragma unroll
                for (int r = 0; r < 16; ++r) oacc[dvt][r] += cacc[r] * qw_; }
        }
        float s1 = 0.f, s2 = 0.f;
#pragma unroll
        for (int dvt = 0; dvt < 2; ++dvt)
#pragma unroll
            for (int r = 0; r < 16; ++r) { const float v = oacc[dvt][r]; s1 += v; s2 += v * v; }
        s1 += __shfl_xor(s1, 32); s2 += __shfl_xor(s2, 32);
        if (h5 == 0) { Xs[(dvh * 128 + 32 * ct + l31) * 2] = s1; Xs[(dvh * 128 + 32 * ct + l31) * 2 + 1] = s2; }
        LDS_BARRIER();
        { LAS float* Ot = (LAS float*)lds;
#pragma unroll
          for (int dvt = 0; dvt < 2; ++dvt)
#pragma unroll
              for (int g_ = 0; g_ < 4; ++g_) *(LAS f32x4*)(Ot + (32 * ct + l31) * 132 + 64 * dvh + 32 * dvt + 8 * g_ + 4 * h5) = (f32x4){oacc[dvt][4 * g_ + 0], oacc[dvt][4 * g_ + 1], oacc[dvt][4 * g_ + 2], oacc[dvt][4 * g_ + 3]};
          LDS_BARRIER();
          const float t1_ = Xs[etok * 2] + Xs[(128 + etok) * 2], t2_ = Xs[etok * 2 + 1] + Xs[(128 + etok) * 2 + 1];
          const float mu = t1_ * (1.f / 128.f); const float var = fmaxf(t2_ * (1.f / 128.f) - mu * mu, 0.f); const float rs = rsqrtf(var + EPS);
          const size_t et = (size_t)tok0 + etok; const int ch0 = h * 128 + 32 * eq; bf16* mp = merged + et * D + ch0;
#pragma unroll
          for (int i = 0; i < 4; ++i) { const f32x4 oa = *(const LAS f32x4*)(Ot + etok * 132 + 32 * eq + 8 * i), ob = *(const LAS f32x4*)(Ot + etok * 132 + 32 * eq + 8 * i + 4);
              const f32x4 ga_ = gnv[i][0], gb_ = gnv[i][1];
              float rgf[8], gaf[8], mwf[8]; unpack8(rgv[i], rgf); unpack8(gav[i], gaf); unpack8(mwv[i], mwf);
              float y[8];
#pragma unroll
              for (int j = 0; j < 4; ++j) { y[j] = (oa[j] - mu) * rs * ga_[j] * siluf_(rgf[j]) * sigmoidf_(gaf[j]) + mwf[j]; y[4 + j] = (ob[j] - mu) * rs * gb_[j] * siluf_(rgf[4 + j]) * sigmoidf_(gaf[4 + j]) + mwf[4 + j]; }
              *(GAS v4u*)(mp + 8 * i) = (v4u){cvtpk_(y[0], y[1]), cvtpk_(y[2], y[3]), cvtpk_(y[4], y[5]), cvtpk_(y[6], y[7])}; } }
        LDS_BARRIER();
    }
#undef R3_LOAD
}

template <int N, int K, int J> __device__ __forceinline__ void bitonic_step(float (&a)[N]) {
#pragma unroll
    for (int i = 0; i < N; ++i) { const int l = i ^ J; if (l > i) { const bool up = ((i & K) == 0); const float lo = fminf(a[i], a[l]), hi = fmaxf(a[i], a[l]); a[i] = up ? hi : lo; a[l] = up ? lo : hi; } }
}
__device__ __forceinline__ void sort16_desc(float (&a)[16]) {
#define CE_(i, j) { const float hi_ = fmaxf(a[i], a[j]), lo_ = fminf(a[i], a[j]); a[i] = hi_; a[j] = lo_; }
    CE_(0, 13) CE_(1, 12) CE_(2, 15) CE_(3, 14) CE_(4, 8) CE_(5, 6) CE_(7, 11) CE_(9, 10)
    CE_(0, 5) CE_(1, 7) CE_(2, 9) CE_(3, 4) CE_(6, 13) CE_(8, 14) CE_(10, 15) CE_(11, 12)
    CE_(0, 1) CE_(2, 3) CE_(4, 5) CE_(6, 8) CE_(7, 9) CE_(10, 11) CE_(12, 13) CE_(14, 15)
    CE_(0, 2) CE_(1, 3) CE_(4, 10) CE_(5, 11) CE_(6, 7) CE_(8, 9) CE_(12, 14) CE_(13, 15)
    CE_(1, 2) CE_(3, 12) CE_(4, 6) CE_(5, 7) CE_(8, 10) CE_(9, 11) CE_(13, 14)
    CE_(1, 4) CE_(2, 6) CE_(5, 8) CE_(7, 10) CE_(9, 13) CE_(11, 14)
    CE_(2, 4) CE_(3, 6) CE_(9, 12) CE_(11, 13)
    CE_(3, 5) CE_(6, 8) CE_(7, 9) CE_(10, 12)
    CE_(3, 4) CE_(5, 6) CE_(7, 8) CE_(9, 10) CE_(11, 12)
    CE_(6, 7) CE_(8, 9)
#undef CE_
}
__device__ __forceinline__ void merge16_desc(float (&a)[16]) { bitonic_step<16, 16, 8>(a); bitonic_step<16, 16, 4>(a); bitonic_step<16, 16, 2>(a); bitonic_step<16, 16, 1>(a); }
__device__ __forceinline__ void top16_merge(float (&a)[16], const float (&b)[16]) {
#pragma unroll
    for (int i = 0; i < 16; ++i) a[i] = fmaxf(a[i], b[15 - i]);
    merge16_desc(a);
}
__device__ __forceinline__ void top16_xlane(float (&a)[16]) {
    float b[16];
#pragma unroll
    for (int i = 0; i < 16; ++i) b[i] = __shfl_xor(a[i], 32);
    top16_merge(a, b);
}
typedef float f32x16v __attribute__((ext_vector_type(16)));
typedef short bf16x8v __attribute__((ext_vector_type(8)));
__device__ __forceinline__ void peer_scores_top16(const LAS unsigned short* Ks, const bf16x8v (&qfr)[8]  , float (&top)[16], int lane) {
    f32x16v acc[4];
#pragma unroll
    for (int t = 0; t < 4; ++t)
#pragma unroll
        for (int r = 0; r < 16; ++r) acc[t][r] = 0.f;
    const LAS unsigned short* kp = Ks + (lane & 31) * 136 + 8 * (lane >> 5);
#pragma unroll
    for (int s_ = 0; s_ < 8; ++s_) {
#pragma unroll
        for (int t = 0; t < 4; ++t) { const bf16x8v kf = *(const LAS bf16x8v*)(kp + t * 32 * 136 + 16 * s_); acc[t] = __builtin_amdgcn_mfma_f32_32x32x16_bf16(kf, qfr[s_], acc[t], 0, 0, 0); } }
    float lst[4][16];
#pragma unroll
    for (int t = 0; t < 4; ++t) {
#pragma unroll
        for (int r = 0; r < 16; ++r) { const unsigned key = (unsigned)(32 * t + (r & 3) + 8 * (r >> 2) + 4 * (lane >> 5)); const float xf_ = acc[t][r];
            lst[t][r] = __builtin_bit_cast(float, (__builtin_bit_cast(unsigned, xf_) & ~0x7Fu) | key); }
        sort16_desc(lst[t]);
    }
    top16_merge(lst[0], lst[1]); top16_merge(lst[2], lst[3]); top16_merge(lst[0], lst[2]);
#pragma unroll
    for (int i = 0; i < 16; ++i) top[i] = lst[0][i];
    top16_xlane(top);
}
__device__ __forceinline__ void phase_peer_topk2(const bf16* qp, const bf16* k1b, const bf16* k2b, int* idxo, float* gateo, LAS unsigned char* lds, int vcu, int G, int tid) {
    const int lane = tid & 63, wave = __builtin_amdgcn_readfirstlane(tid >> 6);
    LAS unsigned short* K1s = (LAS unsigned short*)lds; LAS unsigned short* K2s = (LAS unsigned short*)(lds + 34816);
    const int h5 = lane >> 5;
    int hcur = -1;
    for (int u = vcu; u < 1024; u += G) {
        const int h = u & 7, tb = u >> 3;
        if (h != hcur) {
            __syncthreads();
            v4u kk1[4], kk2[4];
#pragma unroll
            for (int i = 0; i < 4; ++i) { const int idx = tid + NTHR * i, row = idx >> 4, c8 = idx & 15;
                kk1[i] = *(const GAS v4u*)(k1b + ((size_t)h * 128 + row) * 128 + c8 * 8); kk2[i] = *(const GAS v4u*)(k2b + ((size_t)h * 128 + row) * 128 + c8 * 8); }
            asm volatile("" ::: "memory");
#pragma unroll
            for (int i = 0; i < 4; ++i) { const int idx = tid + NTHR * i, row = idx >> 4, c8 = idx & 15;
                *(LAS v4u*)(K1s + row * 136 + c8 * 8) = kk1[i]; *(LAS v4u*)(K2s + row * 136 + c8 * 8) = kk2[i]; }
            __syncthreads(); hcur = h;
        }
        const size_t tok = (size_t)tb * 256 + wave * 32 + (lane & 31);
        const bf16* qrow = qp + tok * NQP + h * 256 + 8 * h5;
        bf16x8v qa[8], qb[8];
#pragma unroll
        for (int s_ = 0; s_ < 8; ++s_) { qa[s_] = *(const GAS bf16x8v*)(qrow + 16 * s_); qb[s_] = *(const GAS bf16x8v*)(qrow + 128 + 16 * s_); }
        float v1[16], v2[16];
        peer_scores_top16(K1s, qa, v1, lane);
        peer_scores_top16(K2s, qb, v2, lane);
        float p[16], q[16]; unsigned pid[16], qid[16];
#pragma unroll
        for (int i = 0; i < 16; ++i) { const float a1_ = v1[i], a2_ = v2[i]; p[i] = h5 ? a2_ : a1_; q[i] = h5 ? a1_ : a2_;
            pid[i] = (__builtin_bit_cast(unsigned, p[i]) & 0x7Fu) << (h5 ? 0 : 7); qid[i] = (__builtin_bit_cast(unsigned, q[i]) & 0x7Fu) << (h5 ? 7 : 0); }
        float c0[16], c1[16]; const float NEGV = -3.0e38f;
#pragma unroll
        for (int i = 0; i < 16; ++i) { c0[i] = NEGV; c1[i] = NEGV; }
        {
            constexpr int NP = 27; constexpr int PA[NP] = {0, 0, 0, 0, 0, 0, 0, 0, 0, 0, 0, 0, 0, 0, 0, 0, 1, 1, 1, 1, 1, 1, 1, 2, 2, 2, 3}; constexpr int PB[NP] = {0, 1, 2, 3, 4, 5, 6, 7, 8, 9, 10, 11, 12, 13, 14, 15, 1, 2, 3, 4, 5, 6, 7, 2, 3, 4, 3};
#pragma unroll
            for (int n = 0; n < NP; ++n) {
                float sv_ = p[PA[n]] + q[PB[n]];
                sv_ = __builtin_bit_cast(float, (__builtin_bit_cast(unsigned, sv_) & ~0x3FFFu) | pid[PA[n]] | qid[PB[n]]);
                if (PA[n] == PB[n]) sv_ = h5 ? NEGV : sv_;
                if (n < 16) c0[n] = sv_; else c1[n - 16] = sv_;
            }
        }
        sort16_desc(c0); sort16_desc(c1); top16_merge(c0, c1); top16_xlane(c0);
        float val[16]; float sm = 0.f;
        { const float mx = __builtin_bit_cast(float, (__builtin_bit_cast(unsigned, c0[0]) & ~0x3FFFu) | 0x2000u);
#pragma unroll
          for (int i = 0; i < 16; ++i) { const float vv = __builtin_bit_cast(float, (__builtin_bit_cast(unsigned, c0[i]) & ~0x3FFFu) | 0x2000u); val[i] = __expf(vv - mx); sm += val[i]; } }
        const float inv = 1.f / sm;
        v4u oi[2]; f32x4 og[2];
#pragma unroll
        for (int k = 0; k < 8; ++k) { const float cl_ = c0[k], ch_ = c0[8 + k], vl_ = val[k], vh_ = val[8 + k]; const float cc = h5 ? ch_ : cl_; const float gg = (h5 ? vh_ : vl_) * inv;
            oi[k >> 2][k & 3] = __builtin_bit_cast(unsigned, cc) & 0x3FFFu; og[k >> 2][k & 3] = gg; }
        int* ip = idxo + tok * 128 + h * 16 + 8 * h5; float* gp = gateo + tok * 128 + h * 16 + 8 * h5;
        *(GAS v4u*)ip = oi[0]; *(GAS v4u*)(ip + 4) = oi[1]; *(GAS f32x4*)gp = og[0]; *(GAS f32x4*)(gp + 4) = og[1];
    }
    __syncthreads();
}


__device__ __forceinline__ void cvt_rows_fp8(const float* src, unsigned char* dst, float* inv_scale, int vcu, int G, int tid) {
    const int lane = tid & 63, wave = __builtin_amdgcn_readfirstlane(tid >> 6);
    const int gw = vcu * NWAVES + wave, NGW = G * NWAVES;
    constexpr int RI = 4;
    for (int row0 = gw; row0 < NEXP; row0 += NGW * RI) {
        f32x4 v[RI][4]; float m[RI];
#pragma unroll
        for (int r = 0; r < RI; ++r) { const int row = row0 + r * NGW; const GAS f32x4* p = (const GAS f32x4*)(src + (size_t)(row < NEXP ? row : gw) * D + 16 * lane);
#pragma unroll
            for (int j = 0; j < 4; ++j) v[r][j] = p[j]; }
#pragma unroll
        for (int r = 0; r < RI; ++r) { float a = 0.f;
#pragma unroll
            for (int j = 0; j < 4; ++j) a = fmaxf(a, fmaxf(fmaxf(fabsf(v[r][j].x), fabsf(v[r][j].y)), fmaxf(fabsf(v[r][j].z), fabsf(v[r][j].w))));
            m[r] = a; }
#pragma unroll
        for (int r = 0; r < RI; ++r) m[r] = wave_max(m[r]);
#pragma unroll
        for (int r = 0; r < RI; ++r) { const int row = row0 + r * NGW; if (row < NEXP) {
            const int e = (int)((__builtin_bit_cast(unsigned, m[r]) >> 23) & 0xffu) - 127;
            const bool ok = (m[r] > 1e-30f);
            const float sc = ok ? __builtin_bit_cast(float, (unsigned)(127 + 7 - e) << 23) : 1.f, inv = ok ? __builtin_bit_cast(float, (unsigned)(127 - 7 + e) << 23) : 1.f;
            v4u o;
#pragma unroll
            for (int j = 0; j < 4; ++j) { int w = __builtin_amdgcn_cvt_pk_fp8_f32(v[r][j].x * sc, v[r][j].y * sc, 0, false); w = __builtin_amdgcn_cvt_pk_fp8_f32(v[r][j].z * sc, v[r][j].w * sc, w, true); o[j] = (unsigned)w; }
            *(GAS v4u*)(dst + (size_t)row * D + 16 * lane) = o;
            if (lane == 0) inv_scale[row] = inv; } }
    }
}
__device__ __forceinline__ void fp8x16_to_f32(const v4u r, f32x2v* f) {
#pragma unroll
    for (int j = 0; j < 4; ++j) { f[2 * j] = __builtin_amdgcn_cvt_pk_f32_fp8((int)r[j], false); f[2 * j + 1] = __builtin_amdgcn_cvt_pk_f32_fp8((int)r[j], true); }
}
__device__ __forceinline__ float erf_as(float x) {
    const float ax = fabsf(x), t = __builtin_amdgcn_rcpf(fmaf(0.3275911f, ax, 1.f));
    const float p = t * fmaf(t, fmaf(t, fmaf(t, fmaf(t, 1.061405429f, -1.453152027f), 1.421413741f), -0.284496736f), 0.254829592f);
    const float r = 1.f - p * __builtin_amdgcn_exp2f(-ax * ax * 1.4426950408889634f);
    return copysignf(r, x);
}
constexpr int GT = 6;
__device__ __forceinline__ float swap_add32(float lo, float hi) { const v2u_ s = __builtin_amdgcn_permlane32_swap(__builtin_bit_cast(unsigned, lo), __builtin_bit_cast(unsigned, hi), false, false); const unsigned a_ = s.x, b_ = s.y; return __builtin_bit_cast(float, a_) + __builtin_bit_cast(float, b_); }
__device__ __forceinline__ float swap_add16(float lo, float hi) { const v2u_ s = __builtin_amdgcn_permlane16_swap(__builtin_bit_cast(unsigned, lo), __builtin_bit_cast(unsigned, hi), false, false); const unsigned a_ = s.x, b_ = s.y; return __builtin_bit_cast(float, a_) + __builtin_bit_cast(float, b_); }
template <int W, int LB> __device__ __forceinline__ void bfly8_step(float (&part)[8], int lane) {
    const bool up = (lane & LB) != 0;
#pragma unroll
    for (int j = 0; j < W; ++j) { const float lo = part[j], hi = part[j + W]; const float send = up ? lo : hi, keep = up ? hi : lo; part[j] = keep + __shfl_xor(send, LB); }
}
__device__ __forceinline__ void phase_peer_gather_lp(const bf16* xn2, const int* idx, const float* gate, const unsigned char* ub, const unsigned char* vb, const float* su, const float* sv,
                                                     bf16* x, float* outf, const float* g2, bool last, const float* ng, const float* nsc, const float* nsh, bf16* xn_next, LAS unsigned char* lds, int vcu, int G, int tid) {
    const int lane = tid & 63, wave = __builtin_amdgcn_readfirstlane(tid >> 6);
    const int gw = vcu * NWAVES + wave, NGW = G * NWAVES;
    constexpr int WB = GT * 1024 + GT * 512;
    LAS int* SE = (LAS int*)(lds + wave * WB); LAS float* SG = (LAS float*)(lds + wave * WB + GT * 512); LAS float* RED = (LAS float*)(lds + wave * WB + GT * 1024);
    const int jj = ((lane >> 5) & 1) * 4 + ((lane >> 4) & 1) * 2 + ((lane >> 3) & 1);
    const unsigned long long below = (1ull << lane) - 1ull;
    const unsigned lane16 = 16u * (unsigned)lane;
    const int TPW = M / NGW;
    for (int tb = 0; tb * GT < TPW; ++tb) {
        const int nt = (TPW - tb * GT < GT) ? TPW - tb * GT : GT;
        v4u hp[GT][2]; f32x2v y2[GT][8];
#pragma unroll
        for (int t = 0; t < GT; ++t) { hp[t][0] = (v4u){0u, 0u, 0u, 0u}; hp[t][1] = hp[t][0]; }
#pragma unroll
        for (int t = 0; t < GT; ++t) if (t < nt) {
            const int tok = gw + (tb * GT + t) * NGW;
            int ls = lane; asm volatile("" : "+v"(ls));
            { const bf16* hr = xn2 + (size_t)tok * D + 16 * ls; hp[t][0] = *(const GAS v4u*)hr; hp[t][1] = *(const GAS v4u*)(hr + 8); }
            const int e0 = idx[(size_t)tok * 128 + ls], e1 = idx[(size_t)tok * 128 + 64 + ls];
            const float g0 = gate[(size_t)tok * 128 + ls], g1 = gate[(size_t)tok * 128 + 64 + ls];
            {
                const int k0 = e0 >> 10, k1 = e1 >> 10;
                unsigned long long m0 = ~0ull, m1 = ~0ull, x10 = ~0ull;
#pragma unroll
                for (int bb = 0; bb < 4; ++bb) { const bool b0 = (k0 >> bb) & 1, b1 = (k1 >> bb) & 1; const unsigned long long B0 = __ballot(b0), B1 = __ballot(b1);
                    m0 &= b0 ? B0 : ~B0; m1 &= b1 ? B1 : ~B1; x10 &= b1 ? B0 : ~B0; }
                const int r0 = __popcll(m0 & below), c0 = __popcll(m0), r1 = __popcll(m1 & below), c1 = __popcll(m1), c01 = __popcll(x10);
                LAS int* H = (LAS int*)(RED + t * 128);
                if (lane < 32) H[lane] = 0;
                if (r0 == 0) H[k0] = c0;
                if (r1 == 0) H[16 + k1] = c1;
                const int tot = H[lane & 15] + H[16 + (lane & 15)];
                asm volatile("s_waitcnt lgkmcnt(0)" ::: "memory");
                int inc = tot;
                inc += __builtin_amdgcn_update_dpp(0, inc, 0x111, 0xf, 0xf, true); inc += __builtin_amdgcn_update_dpp(0, inc, 0x112, 0xf, 0xf, true);
                inc += __builtin_amdgcn_update_dpp(0, inc, 0x114, 0xf, 0xf, true); inc += __builtin_amdgcn_update_dpp(0, inc, 0x118, 0xf, 0xf, true);
                if (lane < 16) H[32 + lane] = inc - tot;
                const int pos0 = H[32 + k0] + r0, pos1 = H[32 + k1] + c01 + r1;
                asm volatile("s_waitcnt lgkmcnt(0)" ::: "memory");
                SE[t * 128 + pos0] = e0; SG[t * 128 + pos0] = g0; SE[t * 128 + pos1] = e1; SG[t * 128 + pos1] = g1;
            }
        }
        asm volatile("s_waitcnt lgkmcnt(0)" ::: "memory");
#pragma unroll 1
        for (int c = 0; c < 16; ++c) {
            if ((c & 3) == 0) __builtin_amdgcn_s_barrier();
#pragma unroll
          for (int th = 0; th < GT; th += 2) if (th < nt) {
            v4u rr[2][8];
#pragma unroll
            for (int t2 = 0; t2 < 2; ++t2) { const int sel = SE[(th + t2) * 128 + 8 * c + (lane & 7)]; const int l0 = 0;
#pragma unroll
                for (int i = 0; i < 8; ++i) { const int e = rl_i(sel, l0 + i); rr[t2][i] = *(const GAS v4u*)((const GAS unsigned char*)ub + (unsigned)(lane16 + ((unsigned)e << 10))); } }
#pragma unroll
            for (int t2 = 0; t2 < 2; ++t2) { const int t = th + t2;
                float part[8]; f32x2v hx[8];
                { float hf[16]; unpack8(hp[t][0], hf); unpack8(hp[t][1], hf + 8);
#pragma unroll
                  for (int j = 0; j < 8; ++j) hx[j] = (f32x2v){hf[2 * j], hf[2 * j + 1]}; }
#pragma unroll
                for (int i = 0; i < 8; ++i) { f32x2v uf[8]; fp8x16_to_f32(rr[t2][i], uf); f32x2v a2 = hx[0] * uf[0];
#pragma unroll
                    for (int q = 1; q < 8; ++q) a2 += hx[q] * uf[q];
                    part[i] = a2.x + a2.y; }
#pragma unroll
                for (int j = 0; j < 4; ++j) part[j] = swap_add32(part[j], part[j + 4]);
                part[0] = swap_add16(part[0], part[2]); part[1] = swap_add16(part[1], part[3]);
                { const float a_ = part[0] + dpp_f<0x128>(part[0]), b_ = part[1] + dpp_f<0x128>(part[1]); part[0] = (lane & 8) ? b_ : a_; }
                float sd_ = part[0]; sd_ += dpp_f<0x141>(sd_); sd_ += dpp_f<0xB1>(sd_); sd_ += dpp_f<0x4E>(sd_);
                if ((lane & 7) == 0) RED[(t * 16 + c) * 8 + jj] = sd_;
            }
          }
        }
        asm volatile("s_waitcnt lgkmcnt(0)" ::: "memory");
        float scu0[GT], scu1[GT], scv0[GT], scv1[GT];
#pragma unroll
        for (int t = 0; t < GT; ++t) { scu0[t] = scu1[t] = scv0[t] = scv1[t] = 0.f; if (t < nt) { const int s0_ = SE[t * 128 + lane], s1_ = SE[t * 128 + 64 + lane]; scu0[t] = su[s0_]; scu1[t] = su[s1_]; scv0[t] = sv[s0_]; scv1[t] = sv[s1_]; } }
#pragma unroll
        for (int t = 0; t < GT; ++t) if (t < nt) {
            const float d0 = RED[t * 128 + lane] * scu0[t], d1 = RED[t * 128 + 64 + lane] * scu1[t];
            const float c0_ = 0.5f * d0 * (1.f + erf_as(d0 * 0.70710678118654752f)) * scv0[t] * SG[t * 128 + lane];
            const float c1_ = 0.5f * d1 * (1.f + erf_as(d1 * 0.70710678118654752f)) * scv1[t] * SG[t * 128 + 64 + lane];
            asm volatile("s_waitcnt lgkmcnt(0)" ::: "memory");
            RED[t * 128 + lane] = c0_; RED[t * 128 + 64 + lane] = c1_;
        }
        asm volatile("s_waitcnt lgkmcnt(0)" ::: "memory");
#pragma unroll
        for (int t = 0; t < GT; ++t)
#pragma unroll
            for (int j = 0; j < 8; ++j) y2[t][j] = (f32x2v){0.f, 0.f};
#pragma unroll 1
        for (int c = 0; c < 16; ++c) {
            if ((c & 3) == 0) __builtin_amdgcn_s_barrier();
#pragma unroll
          for (int th = 0; th < GT; th += 2) if (th < nt) {
            v4u rr[2][8];
#pragma unroll
            for (int t2 = 0; t2 < 2; ++t2) { const int sel = SE[(th + t2) * 128 + 8 * c + (lane & 7)]; const int l0 = 0;
#pragma unroll
                for (int i = 0; i < 8; ++i) { const int e = rl_i(sel, l0 + i); rr[t2][i] = *(const GAS v4u*)((const GAS unsigned char*)vb + (unsigned)(lane16 + ((unsigned)e << 10))); } }
#pragma unroll
            for (int t2 = 0; t2 < 2; ++t2) { const int t = th + t2;
                const float coef = RED[(t * 16 + c) * 8 + jj];
#pragma unroll
                for (int i = 0; i < 8; ++i) { f32x2v vf[8]; fp8x16_to_f32(rr[t2][i], vf); const float cf = rl_f(coef, 32 * ((i >> 2) & 1) + 16 * ((i >> 1) & 1) + 8 * (i & 1));
#pragma unroll
                    for (int q = 0; q < 8; ++q) y2[t][q] += vf[q] * cf; }
            }
          }
        }
        asm volatile("s_waitcnt lgkmcnt(0)" ::: "memory");
        int lt = lane; asm volatile("" : "+v"(lt));
#pragma unroll
        for (int t = 0; t < GT; ++t) if (t < nt) {
            const int tok = gw + (tb * GT + t) * NGW; const int b = tok >> 12;
            bf16* xr = x + (size_t)tok * XP + 16 * lt; const float* gr = g2 + (size_t)b * MODW + 16 * lt;
            const float* scp = nsc + (size_t)b * MODW + 16 * lt; const float* shp = nsh + (size_t)b * MODW + 16 * lt;
            const v4u xw0 = *(const GAS v4u*)xr, xw1 = *(const GAS v4u*)(xr + 8);
            f32x4 gav[4];
#pragma unroll
            for (int q = 0; q < 4; ++q) gav[q] = *(const GAS f32x4*)(gr + 4 * q);
            asm volatile("" ::: "memory");
            f32x4 xv[4]; float ss = 0.f;
            { float xf[16]; unpack8(xw0, xf); unpack8(xw1, xf + 8);
#pragma unroll
            for (int q = 0; q < 4; ++q) { const f32x4 xa = (f32x4){xf[4 * q], xf[4 * q + 1], xf[4 * q + 2], xf[4 * q + 3]};
                const f32x4 yy = (f32x4){y2[t][2 * q].x, y2[t][2 * q].y, y2[t][2 * q + 1].x, y2[t][2 * q + 1].y};
                xv[q] = xa + gav[q] * yy; ss += (xv[q].x * xv[q].x + xv[q].y * xv[q].y) + (xv[q].z * xv[q].z + xv[q].w * xv[q].w); } }
            if (last) {
                f32x4 ngv[4];
#pragma unroll
                for (int q = 0; q < 4; ++q) ngv[q] = *(const GAS f32x4*)(ng + 16 * lt + 4 * q);
                asm volatile("" ::: "memory");
                const float rstd = rsqrtf(wave_sum(ss) * (1.f / D) + EPS);
                float* orow = outf + (size_t)tok * D + 16 * lt;
#pragma unroll
                for (int q = 0; q < 4; ++q) *(GAS f32x4*)(orow + 4 * q) = xv[q] * rstd * ngv[q];
            } else {
                f32x4 ngv[4], scv_[4], shv_[4];
#pragma unroll
                for (int q = 0; q < 4; ++q) { ngv[q] = *(const GAS f32x4*)(ng + 16 * lt + 4 * q); scv_[q] = *(const GAS f32x4*)(scp + 4 * q); shv_[q] = *(const GAS f32x4*)(shp + 4 * q); }
                asm volatile("" ::: "memory");
                const float rstd = rsqrtf(wave_sum(ss) * (1.f / D) + EPS);
                bf16* orow = xn_next + (size_t)tok * D + 16 * lt;
                unsigned pk[8], px[8];
#pragma unroll
                for (int q = 0; q < 4; ++q) { px[2 * q] = pk2(xv[q].x, xv[q].y); px[2 * q + 1] = pk2(xv[q].z, xv[q].w);
                    const f32x4 hn = (xv[q] * rstd * ngv[q]) * (scv_[q] + 1.0f) + shv_[q]; pk[2 * q] = pk2(hn.x, hn.y); pk[2 * q + 1] = pk2(hn.z, hn.w); }
                *(GAS v4u*)xr = (v4u){px[0], px[1], px[2], px[3]}; *(GAS v4u*)(xr + 8) = (v4u){px[4], px[5], px[6], px[7]};
                *(GAS v4u*)orow = (v4u){pk[0], pk[1], pk[2], pk[3]}; *(GAS v4u*)(orow + 8) = (v4u){pk[4], pk[5], pk[6], pk[7]};
            }
        }
    }
}

constexpr int PH_PER_LAYER = 11, N_PHASES = 2 + DEPTH * PH_PER_LAYER;
#ifndef PHASE_MASK
#define PHASE_MASK 0xFFFF
#endif
#define PM(k) ((PHASE_MASK >> (k)) & 1)
#ifndef MK_PER_PHASE
#define MK_PER_PHASE 0
#endif
__global__ void __launch_bounds__(NTHR, 2) mk_fwd(Args args) {
    extern __shared__ __attribute__((aligned(16))) unsigned char lds_raw[];
    LAS unsigned char* lds = (LAS unsigned char*)lds_raw;
    const int tid0 = threadIdx.x;
    const int G = gridDim.x; const int bx = blockIdx.x; const int vcu = (G % 8 == 0) ? (bx % 8) * (G / 8) + bx / 8 : bx;
    for (int u = tid0; u < (LDS_BYTES - LDSCTL_OFF) / 4; u += NTHR) ((LAS unsigned*)(lds + LDSCTL_OFF))[u] = 0u;
    __syncthreads();
    XcdBarrier bar; bar.bar = (unsigned*)(args.ws + WS_CTL) + CW_BAR; bar.x = 0; bar.st = nullptr;
    if (!MK_PER_PHASE) bar = xcd_barrier_post((unsigned*)(args.ws + WS_CTL) + CW_BAR, (volatile LAS unsigned*)(lds + LDSCTL_OFF) + 8);
    for (int p = args.ph_lo; p < args.ph_hi; ++p) {
        int tid = tid0; asm volatile("" : "+v"(tid));
        unsigned char* ws = args.ws; asm volatile("" : "+s"(ws));
        float* modp = (float*)(ws + WS_MOD);
        int l = 0, r = -1;
        if (p >= 2) { l = (p - 2) / PH_PER_LAYER; r = (p - 2) % PH_PER_LAYER; }
        const float* modl = modp + (size_t)l * 8 * MODW;
        if (p == 0) { if (PM(0)) phase_prologue(args, lds, vcu, G, tid); }
        else if (p == 1 || r == 7) {
            if (PM(1)) {
                if (p == 1) phase_norm(args.in[0], args.in[5], modl + 1024, modl + 0, (bf16*)(ws + WS_XN), vcu, G, tid);
                else { phase_norm_b((const bf16*)args.out, args.in[6] + l * D, modl + 4096, modl + 3072, (bf16*)(ws + WS_XN), vcu, G, tid); cvt_rows_fp8(args.in[14] + (size_t)l * NEXP * D, ws + WS_U8, (float*)(ws + WS_SU), vcu, G, tid);
                    cvt_rows_fp8(args.in[15] + (size_t)l * NEXP * D, ws + WS_V8, (float*)(ws + WS_SV), vcu, G, tid); }
            }
        }
        else if (r == 0 || r == 2 || r == 8) {
            if (PM(2)) {
                const bf16* Bt; int N; bf16* O;
                if (r == 0) { Bt = (const bf16*)(ws + WS_WIN) + (size_t)l * NIN * D + (size_t)NA * D; N = NB; O = (bf16*)(ws + WS_PROJ); }
                else if (r == 2) { Bt = (const bf16*)(ws + WS_WIN) + (size_t)l * NIN * D; N = NA; O = (bf16*)(ws + WS_PROJ); }
                else { Bt = (const bf16*)(ws + WS_WQ) + (size_t)l * NQP * D; N = NQP; O = (bf16*)(ws + WS_QP); }
                pg8::Gemm g{(const bf16*)(ws + WS_XN), Bt, M, N, D}; pg8::StaticOrder S; S.init(M, N, G, bx);
                pg8::EpiBf16 E{O, N};
                pg8::gemm_phase<pg8::EpiBf16, pg8::StaticOrder, PG8_ALIGN, PG8_SP2>(lds, g, S, E);
            }
        }
        else if (r == 1) { if (PM(3)) phase_swa_mfma((const bf16*)(ws + WS_PROJ), (const unsigned*)(ws + WS_ROPE_A), args.in[9] + l * 16, (bf16*)(ws + WS_MERGED), lds, vcu, G, tid); }
        else if (r == 3) { if (PM(4)) phase_ret_kv_mfma((const bf16*)(ws + WS_PROJ), (const unsigned*)(ws + WS_ROPE_R), (float*)(ws + WS_XN), lds, vcu, G, tid); }
        else if (r == 4) { if (PM(5)) phase_ret_scan2((const float*)(ws + WS_XN), (bf16*)(ws + WS_PREVT), vcu, G, tid); }
        else if (r == 5) { if (PM(6)) phase_ret_out_mfma((const bf16*)(ws + WS_PROJ), (const unsigned*)(ws + WS_ROPE_R), (const bf16*)(ws + WS_PREVT), args.in[8] + l * D, (bf16*)(ws + WS_MERGED), lds, vcu, G, tid); }
        else if (r == 6) {
            if (PM(7)) {
                pg8::Gemm g{(const bf16*)(ws + WS_MERGED), (const bf16*)(ws + WS_WOUT) + (size_t)l * D * D, M, D, D}; pg8::StaticOrder S; S.init(M, D, G, bx);
                pg8::EpiResGateB E{l == 0 ? (const void*)args.in[0] : (const void*)args.out, l == 0 ? D : XP, l != 0, (pg8::bf16_t*)args.out, XP, modl + 2048, MODW};
                pg8::gemm_phase<pg8::EpiResGateB, pg8::StaticOrder, PG8_ALIGN, PG8_SP2>(lds, g, S, E);
            }
        }
        else if (r == 9) { if (PM(8)) phase_peer_topk2((const bf16*)(ws + WS_QP), (const bf16*)(ws + WS_K1) + (size_t)l * 8 * 128 * 128, (const bf16*)(ws + WS_K2) + (size_t)l * 8 * 128 * 128, (int*)(ws + WS_IDX), (float*)(ws + WS_GATE), lds, vcu, G, tid); }
        else {
            if (PM(9)) {
                const bool last = (l == DEPTH - 1);
                const float* modn = modp + (size_t)(last ? l : l + 1) * 8 * MODW;
                phase_peer_gather_lp((const bf16*)(ws + WS_XN), (const int*)(ws + WS_IDX), (const float*)(ws + WS_GATE), ws + WS_U8, ws + WS_V8, (const float*)(ws + WS_SU), (const float*)(ws + WS_SV), (bf16*)args.out, args.out, modl + 5120,
                                  last, last ? args.in[16] : args.in[5] + (l + 1) * D, modn + 1024, modn + 0, (bf16*)(ws + WS_XN), lds, vcu, G, tid);
            }
        }
        if (!MK_PER_PHASE && p + 1 < args.ph_hi) xcd_barrier(bar);
    }
}

extern "C" void kernel_launch(void* const* d_in, const int* in_sizes, int n_in, void* d_out, int out_size, void* d_ws, size_t ws_size, hipStream_t stream) {
    static int grid = 0;
    if (grid == 0) {
        if (n_in != 17 || in_sizes[0] != M * D || out_size != M * D || ws_size < WS_END) { fprintf(stderr, "kernel_launch: unexpected problem (n_in %d, in0 %d, out %d, ws %zu < %zu); nothing launched\n", n_in, n_in > 0 ? in_sizes[0] : -1, out_size, ws_size, (size_t)WS_END); grid = -1; return; }
        int dev = 0, cus = 0, per_cu = 0;
        if (hipGetDevice(&dev) != hipSuccess || hipDeviceGetAttribute(&cus, hipDeviceAttributeMultiprocessorCount, dev) != hipSuccess) { grid = -1; return; }
        if (hipFuncSetAttribute((const void*)mk_fwd, hipFuncAttributeMaxDynamicSharedMemorySize, LDS_BYTES) != hipSuccess) { fprintf(stderr, "kernel_launch: hipFuncSetAttribute failed\n"); grid = -1; return; }
        if (hipOccupancyMaxActiveBlocksPerMultiprocessor(&per_cu, (const void*)mk_fwd, NTHR, LDS_BYTES) != hipSuccess || per_cu < 1) { fprintf(stderr, "kernel_launch: occupancy query says %d blocks per CU; nothing launched\n", per_cu); (void)hipGetLastError(); grid = -1; return; }
        (void)hipGetLastError();
        if (cus != 256) { fprintf(stderr, "kernel_launch: built for a 256-CU device (MI355X), found %d CUs; nothing launched\n", cus); grid = -1; return; }
        grid = cus;
    }
    if (grid < 0) return;
    if (hipMemsetAsync((char*)d_ws + WS_CTL, 0, CTL_ZERO_BYTES, stream) != hipSuccess) return;
    Args a{};
    for (int i = 0; i < 17; ++i) a.in[i] = (const float*)d_in[i];
    a.out = (float*)d_out; a.ws = (unsigned char*)d_ws;
#if MK_PER_PHASE
    for (int p = 0; p < N_PHASES; ++p) { a.ph_lo = p; a.ph_hi = p + 1; a.li = 0; hipLaunchKernelGGL(mk_fwd, dim3(grid), dim3(NTHR), LDS_BYTES, stream, a); }
#else
    a.ph_lo = 0; a.ph_hi = N_PHASES; a.li = 0;
    hipLaunchKernelGGL(mk_fwd, dim3(grid), dim3(NTHR), LDS_BYTES, stream, a);
#endif
}
```

```cpp
#include <hip/hip_runtime.h>
#include <cstdio>
#include <cstdint>
#include <cmath>
namespace pg8 {
#define PG8_LAS __attribute__((address_space(3)))
typedef unsigned short bf16_t;
typedef short bf16x8 __attribute__((ext_vector_type(8)));
typedef float f32x4 __attribute__((ext_vector_type(4)));
typedef unsigned u32x4 __attribute__((ext_vector_type(4)));
constexpr int BM = 256, BK = 64, HALF = 128, HTB = HALF * BK * 2  , STAGE_BYTES = 8 * HTB, NXCD = 8, WGM = 8;

__host__ __device__ __forceinline__ int lds_byte(int r, int c) { const int st = (r >> 4) * 2 + (c >> 5), rr = r & 15, cc = c & 31, ob = rr * 64 + cc * 2; return st * 1024 + (ob ^ (((ob >> 9) & 1) << 5)); }
__host__ __device__ __forceinline__ void stage_rc(int b, int& R, int& C) { const int st = b / 1024, sb = b % 1024, swz = sb ^ (((sb >> 9) & 1) << 5); R = (st >> 1) * 16 + swz / 64; C = (st & 1) * 32 + (swz % 64) / 2; }
__host__ __device__ __forceinline__ int perm32(int rho) { const int n = rho >> 4, i = rho & 15; return 8 * (i >> 2) + 4 * n + (i & 3); }

struct Unit { int pm, pn; };
struct Gemm { const bf16_t* A; const bf16_t* Bt; int M, N, K; };

struct StaticOrder {
    int nM, nN, nwg, G, c;
    __host__ __device__ void init(int M, int N, int G_, int c_) { nM = M / BM; nN = N / BM; nwg = nM * nN; G = G_; c = c_; }
    __host__ __device__ bool next(int i, Unit& u) const {
        const long L = (long)i * G + c; if (L >= nwg) return false;
        int wgid = (int)L; { const int q = nwg / NXCD, r = nwg % NXCD, xcd = wgid % NXCD, off = wgid / NXCD; wgid = (xcd < r ? xcd * (q + 1) : r * (q + 1) + (xcd - r) * q) + off; }
        const int nig = WGM * nN, gid = wgid / nig, fm = gid * WGM, gsz = (nM - fm) < WGM ? (nM - fm) : WGM;
        u.pm = fm + ((wgid % nig) % gsz); u.pn = (wgid % nig) / gsz; return true;
    }
    __device__ __forceinline__ void a_ready(const Unit&) const {}
    __device__ __forceinline__ void done(const Unit&) const {}
};

__device__ __forceinline__ unsigned cvt_pk_bf16(float lo, float hi) { unsigned r; asm volatile("v_cvt_pk_bf16_f32 %0, %1, %2" : "=v"(r) : "v"(lo), "v"(hi)); return r; }
typedef float f32x2 __attribute__((ext_vector_type(2)));
struct EpiBf16 {
    static constexpr bool PERM = true, AFTER_DRAIN = false;
    bf16_t* O; int ldc;
    __device__ __forceinline__ void operator()(const f32x4 (&acc)[2][2][4][2], const Unit& u, int wr, int wc, int fr, int fq) const {
        const int row0 = u.pm * BM + wr * 64 + fr; const int col0 = u.pn * BM + wc * 32 + 8 * fq;
#pragma unroll
        for (int ai = 0; ai < 2; ++ai)
#pragma unroll
            for (int m = 0; m < 4; ++m) { bf16_t* rowp = O + (size_t)(row0 + ai * HALF + m * 16) * ldc + col0;
#pragma unroll
                for (int bj = 0; bj < 2; ++bj) { const f32x4 v0 = acc[ai][bj][m][0], v1 = acc[ai][bj][m][1];
                    u32x4 w; w.x = cvt_pk_bf16(v0[0], v0[1]); w.y = cvt_pk_bf16(v0[2], v0[3]); w.z = cvt_pk_bf16(v1[0], v1[1]); w.w = cvt_pk_bf16(v1[2], v1[3]);
                    *(u32x4*)(rowp + bj * HALF) = w; } }
    }
};
struct EpiResGate {
    static constexpr bool PERM = false, AFTER_DRAIN = false;
    const float* xin; float* xout; const float* gate; int gate_ld; int ldc;
    __device__ __forceinline__ void operator()(const f32x4 (&acc)[2][2][4][2], const Unit& u, int wr, int wc, int fr, int fq) const {
        const int col0 = u.pn * BM + wc * 32 + 4 * fq; const int b = (u.pm * BM) >> 12;
        f32x4 gv[2][2];
#pragma unroll
        for (int bj = 0; bj < 2; ++bj)
#pragma unroll
            for (int n = 0; n < 2; ++n) gv[bj][n] = *(const f32x4*)(gate + (size_t)b * gate_ld + col0 + bj * HALF + n * 16);
#pragma unroll
        for (int ai = 0; ai < 2; ++ai)
#pragma unroll
            for (int m = 0; m < 4; ++m) { const size_t off = (size_t)(u.pm * BM + ai * HALF + wr * 64 + m * 16 + fr) * ldc + col0;
#pragma unroll
                for (int bj = 0; bj < 2; ++bj)
#pragma unroll
                    for (int n = 0; n < 2; ++n) { const f32x4 xi = *(const f32x4*)(xin + off + bj * HALF + n * 16); *(f32x4*)(xout + off + bj * HALF + n * 16) = xi + gv[bj][n] * acc[ai][bj][m][n]; } }
    }
};
struct EpiResGateB {
    static constexpr bool PERM = true, AFTER_DRAIN = false;
    const void* xin; int ldi; bool in_bf16; bf16_t* xout; int ldo; const float* gate; int gate_ld;
    __device__ __forceinline__ void operator()(const f32x4 (&acc)[2][2][4][2], const Unit& u, int wr, int wc, int fr, int fq) const {
        const int row0 = u.pm * BM + wr * 64 + fr; const int col0 = u.pn * BM + wc * 32 + 8 * fq; const int b = (u.pm * BM) >> 12;
        f32x4 gv[2][2];
#pragma unroll
        for (int bj = 0; bj < 2; ++bj)
#pragma unroll
            for (int n = 0; n < 2; ++n) gv[bj][n] = *(const f32x4*)(gate + (size_t)b * gate_ld + col0 + bj * HALF + n * 4);
        if (in_bf16) {
#pragma unroll
            for (int ai = 0; ai < 2; ++ai) {
                u32x4 w[4][2];
#pragma unroll
                for (int m = 0; m < 4; ++m)
#pragma unroll
                    for (int bj = 0; bj < 2; ++bj) w[m][bj] = *(const u32x4*)((const bf16_t*)xin + (size_t)(row0 + ai * HALF + m * 16) * ldi + col0 + bj * HALF);
                asm volatile("" ::: "memory");
#pragma unroll
                for (int m = 0; m < 4; ++m) { const size_t row = (size_t)(row0 + ai * HALF + m * 16);
#pragma unroll
                    for (int bj = 0; bj < 2; ++bj) { const u32x4 ww = w[m][bj];
                        const f32x4 x0 = {__builtin_bit_cast(float, ww.x << 16), __builtin_bit_cast(float, ww.x & 0xffff0000u), __builtin_bit_cast(float, ww.y << 16), __builtin_bit_cast(float, ww.y & 0xffff0000u)};
                        const f32x4 x1 = {__builtin_bit_cast(float, ww.z << 16), __builtin_bit_cast(float, ww.z & 0xffff0000u), __builtin_bit_cast(float, ww.w << 16), __builtin_bit_cast(float, ww.w & 0xffff0000u)};
                        const f32x4 v0 = x0 + gv[bj][0] * acc[ai][bj][m][0], v1 = x1 + gv[bj][1] * acc[ai][bj][m][1];
                        u32x4 o; o.x = cvt_pk_bf16(v0[0], v0[1]); o.y = cvt_pk_bf16(v0[2], v0[3]); o.z = cvt_pk_bf16(v1[0], v1[1]); o.w = cvt_pk_bf16(v1[2], v1[3]);
                        *(u32x4*)(xout + row * ldo + col0 + bj * HALF) = o; } }
            }
        } else {
#pragma unroll
            for (int ai = 0; ai < 2; ++ai)
#pragma unroll
                for (int mh = 0; mh < 2; ++mh) {
                    f32x4 xa[2][2][2];
#pragma unroll
                    for (int m2 = 0; m2 < 2; ++m2)
#pragma unroll
                        for (int bj = 0; bj < 2; ++bj) { const float* xp = (const float*)xin + (size_t)(row0 + ai * HALF + (2 * mh + m2) * 16) * ldi + col0 + bj * HALF; xa[m2][bj][0] = *(const f32x4*)xp; xa[m2][bj][1] = *(const f32x4*)(xp + 4); }
                    asm volatile("" ::: "memory");
#pragma unroll
                    for (int m2 = 0; m2 < 2; ++m2) { const int m = 2 * mh + m2; const size_t row = (size_t)(row0 + ai * HALF + m * 16);
#pragma unroll
                        for (int bj = 0; bj < 2; ++bj) {
                            const f32x4 v0 = xa[m2][bj][0] + gv[bj][0] * acc[ai][bj][m][0], v1 = xa[m2][bj][1] + gv[bj][1] * acc[ai][bj][m][1];
                            u32x4 o; o.x = cvt_pk_bf16(v0[0], v0[1]); o.y = cvt_pk_bf16(v0[2], v0[3]); o.z = cvt_pk_bf16(v1[0], v1[1]); o.w = cvt_pk_bf16(v1[2], v1[3]);
                            *(u32x4*)(xout + row * ldo + col0 + bj * HALF) = o; } }
                }
        }
    }
};
template <class Epi, class Sched, bool ALIGN_EPI = false, bool SP2 = false>
__device__ __forceinline__ void gemm_phase(PG8_LAS unsigned char* lds, const Gemm g, const Sched& S, const Epi& E) {
    int tid_ = threadIdx.x; asm volatile("" : "+v"(tid_));
    const int tid = tid_, wid = __builtin_amdgcn_readfirstlane(tid >> 6), lane = tid & 63, wr = wid >> 2, wc = wid & 3, fr = lane & 15, fq = lane >> 4;
    const int K = g.K, nt = K / BK;
    unsigned voffA[2], voffB[2];
#pragma unroll
    for (int i = 0; i < 2; ++i) { int R, C; stage_rc(tid * 16 + i * 8192, R, C); const int Rb = Epi::PERM ? ((R & ~31) + perm32(R & 31)) : R;
        voffA[i] = (unsigned)(R * K + C) * 2u; voffB[i] = (unsigned)(Rb * K + C) * 2u; }
    const size_t kstep = (size_t)(BK * 2);
    const size_t hstep = (size_t)HALF * K * 2;
    const size_t tstep = 2 * hstep;
    const unsigned ldsw = (unsigned)wid * 1024u;
    const int aoff = lds_byte(wr * 64 + fr, fq * 8), boff = lds_byte(wc * 32 + fr, fq * 8);
#define PG8_SA(b, h) (((b) * 2 + (h)) * HTB)
#define PG8_SB(b, h) ((4 + (b) * 2 + (h)) * HTB)
#define PG8_STAGE(bufoff, gbase, voff) do { _Pragma("unroll") for (int _i = 0; _i < 2; ++_i) \
        __builtin_amdgcn_global_load_lds((const unsigned*)((const char*)(gbase) + (voff)[_i]), (PG8_LAS unsigned*)(lds + (bufoff) + ldsw + _i * 8192), 16, 0, 0); } while (0)
#define PG8_LDA(dst, b, h) do { _Pragma("unroll") for (int m = 0; m < 4; ++m) _Pragma("unroll") for (int k = 0; k < 2; ++k) dst[m][k] = *(const PG8_LAS bf16x8*)(lds + PG8_SA(b, h) + aoff + m * 2048 + k * 1024); } while (0)
#define PG8_LDB(dst, b, h) do { _Pragma("unroll") for (int n = 0; n < 2; ++n) _Pragma("unroll") for (int k = 0; k < 2; ++k) dst[n][k] = *(const PG8_LAS bf16x8*)(lds + PG8_SB(b, h) + boff + n * 2048 + k * 1024); } while (0)
#define PG8_MMA(ai, bj, At, Bt) do { __builtin_amdgcn_s_setprio(1); _Pragma("unroll") for (int m = 0; m < 4; ++m) _Pragma("unroll") for (int n = 0; n < 2; ++n) _Pragma("unroll") for (int k = 0; k < 2; ++k) \
        acc[ai][bj][m][n] = __builtin_amdgcn_mfma_f32_16x16x32_bf16(Bt[n][k], At[m][k], acc[ai][bj][m][n], 0, 0, 0); __builtin_amdgcn_s_setprio(0); } while (0)
#define PG8_WAIT_V(n) asm volatile("s_waitcnt vmcnt(" #n ")" ::: "memory")
#define PG8_WAIT_L(n) asm volatile("s_waitcnt lgkmcnt(" #n ")" ::: "memory")
#define PG8_BAR __builtin_amdgcn_s_barrier()
#define PG8_SCHED __builtin_amdgcn_sched_barrier(0)
    Unit cur, nxt; int ui = 0;
    if (!S.next(0, cur)) return;
    f32x4 acc[2][2][4][2];
#pragma unroll
    for (int a = 0; a < 2; ++a)
#pragma unroll
        for (int b = 0; b < 2; ++b)
#pragma unroll
            for (int m = 0; m < 4; ++m)
#pragma unroll
                for (int n = 0; n < 2; ++n) acc[a][b][m][n] = (f32x4){0.f, 0.f, 0.f, 0.f};
    bf16x8 At[4][2], B0[2][2], B1[2][2];
    const char* cA = (const char*)g.A + (size_t)cur.pm * tstep; const char* cB = (const char*)g.Bt + (size_t)cur.pn * tstep;
    S.a_ready(cur);
    if constexpr (SP2) {
        PG8_STAGE(PG8_SB(0, 0), cB, voffB); PG8_STAGE(PG8_SB(0, 1), cB + hstep, voffB); PG8_STAGE(PG8_SA(0, 0), cA, voffA); PG8_STAGE(PG8_SA(0, 1), cA + hstep, voffA);
        if (wr == 1) PG8_BAR;
        PG8_WAIT_V(2); PG8_BAR;
        PG8_STAGE(PG8_SB(1, 0), cB + kstep, voffB); PG8_STAGE(PG8_SA(1, 0), cA + kstep, voffA); PG8_STAGE(PG8_SB(1, 1), cB + hstep + kstep, voffB);
        PG8_WAIT_V(6); PG8_BAR;
    } else {
        PG8_STAGE(PG8_SB(0, 0), cB, voffB); PG8_STAGE(PG8_SA(0, 0), cA, voffA); PG8_STAGE(PG8_SB(0, 1), cB + hstep, voffB); PG8_STAGE(PG8_SA(0, 1), cA + hstep, voffA);
        if (wr == 1) PG8_BAR;
        PG8_WAIT_V(4); PG8_BAR;
        PG8_STAGE(PG8_SB(1, 0), cB + kstep, voffB); PG8_STAGE(PG8_SA(1, 0), cA + kstep, voffA); PG8_STAGE(PG8_SB(1, 1), cB + hstep + kstep, voffB);
        PG8_WAIT_V(6); PG8_BAR;
    }
    for (;;) {
        const bool has_next = S.next(ui + 1, nxt);
        const char* nA = has_next ? (const char*)g.A + (size_t)nxt.pm * tstep : cA; const char* nB = has_next ? (const char*)g.Bt + (size_t)nxt.pn * tstep : cB;
        for (int t = 0; t < nt; t += 2) {
            const bool last = (t == nt - 2);
            const char* a1 = cA + (size_t)(t + 1) * kstep;
            const char* a2 = last ? nA : cA + (size_t)(t + 2) * kstep; const char* b2 = last ? nB : cB + (size_t)(t + 2) * kstep;
            const char* a3 = a2 + kstep; const char* b3 = b2 + kstep;
            if (last && has_next) S.a_ready(nxt);
            if constexpr (SP2) {
            PG8_LDB(B0, 0, 0); PG8_LDB(B1, 0, 1); PG8_SCHED; PG8_LDA(At, 0, 0); PG8_STAGE(PG8_SA(1, 1), a1 + hstep, voffA);
            PG8_WAIT_V(8); PG8_WAIT_L(0); PG8_BAR; PG8_MMA(0, 0, At, B0); PG8_MMA(0, 1, At, B1); PG8_BAR; PG8_SCHED;
            PG8_LDA(At, 0, 1); PG8_STAGE(PG8_SB(0, 0), b2, voffB); PG8_STAGE(PG8_SB(0, 1), b2 + hstep, voffB); PG8_STAGE(PG8_SA(0, 0), a2, voffA);
            PG8_WAIT_V(8); PG8_WAIT_L(0); PG8_BAR; PG8_MMA(1, 0, At, B0); PG8_MMA(1, 1, At, B1); PG8_BAR; PG8_SCHED;
            PG8_LDB(B0, 1, 0); PG8_LDB(B1, 1, 1); PG8_SCHED; PG8_LDA(At, 1, 0); PG8_STAGE(PG8_SA(0, 1), a2 + hstep, voffA);
            PG8_WAIT_V(8); PG8_WAIT_L(0); PG8_BAR; PG8_MMA(0, 0, At, B0); PG8_MMA(0, 1, At, B1); PG8_BAR; PG8_SCHED;
            PG8_LDA(At, 1, 1); PG8_STAGE(PG8_SB(1, 0), b3, voffB); PG8_STAGE(PG8_SB(1, 1), b3 + hstep, voffB); PG8_STAGE(PG8_SA(1, 0), a3, voffA);
            PG8_WAIT_V(8); PG8_WAIT_L(0); PG8_BAR; PG8_MMA(1, 0, At, B0); PG8_MMA(1, 1, At, B1); PG8_BAR; PG8_SCHED;
            } else {
            PG8_LDB(B0, 0, 0); PG8_SCHED; PG8_LDA(At, 0, 0); PG8_STAGE(PG8_SA(1, 1), a1 + hstep, voffA);
            PG8_WAIT_L(8); PG8_BAR; PG8_WAIT_L(0); PG8_MMA(0, 0, At, B0); PG8_BAR; PG8_SCHED;
            PG8_LDB(B1, 0, 1); PG8_STAGE(PG8_SB(0, 0), b2, voffB);
            PG8_BAR; PG8_WAIT_L(0); PG8_MMA(0, 1, At, B1); PG8_BAR;
            PG8_LDA(At, 0, 1); PG8_STAGE(PG8_SA(0, 0), a2, voffA);
            PG8_BAR; PG8_WAIT_L(0); PG8_MMA(1, 0, At, B0); PG8_BAR; PG8_SCHED;
            PG8_STAGE(PG8_SB(0, 1), b2 + hstep, voffB);
            PG8_WAIT_V(6); PG8_BAR; PG8_MMA(1, 1, At, B1); PG8_BAR;
            PG8_LDB(B0, 1, 0); PG8_SCHED; PG8_LDA(At, 1, 0); PG8_STAGE(PG8_SA(0, 1), a2 + hstep, voffA);
            PG8_WAIT_L(8); PG8_BAR; PG8_WAIT_L(0); PG8_MMA(0, 0, At, B0); PG8_BAR; PG8_SCHED;
            PG8_LDB(B1, 1, 1); PG8_STAGE(PG8_SB(1, 0), b3, voffB);
            PG8_BAR; PG8_WAIT_L(0); PG8_MMA(0, 1, At, B1); PG8_BAR;
            PG8_LDA(At, 1, 1); PG8_STAGE(PG8_SA(1, 0), a3, voffA);
            PG8_BAR; PG8_WAIT_L(0); PG8_MMA(1, 0, At, B0); PG8_BAR; PG8_SCHED;
            PG8_STAGE(PG8_SB(1, 1), b3 + hstep, voffB);
            PG8_WAIT_V(6); PG8_BAR; PG8_MMA(1, 1, At, B1); PG8_BAR;
            }
        }
        if constexpr (ALIGN_EPI) { if (wr == 0) PG8_BAR; }
        if constexpr (!Epi::AFTER_DRAIN) { E(acc, cur, wr, wc, fr, fq); S.done(cur); }
        if (!has_next) break;
#pragma unroll
        for (int a = 0; a < 2; ++a)
#pragma unroll
            for (int b = 0; b < 2; ++b)
#pragma unroll
                for (int m = 0; m < 4; ++m)
#pragma unroll
                    for (int n = 0; n < 2; ++n) acc[a][b][m][n] = (f32x4){0.f, 0.f, 0.f, 0.f};
        cur = nxt; cA = nA; cB = nB; ++ui;
        if constexpr (ALIGN_EPI) { if (wr == 1) PG8_BAR; }
    }
    PG8_WAIT_V(0);
    if constexpr (!ALIGN_EPI) { if (wr == 0) PG8_BAR; }
    PG8_BAR;
    if constexpr (Epi::AFTER_DRAIN) { E.fused(acc, cur, wr, wc, fr, fq, lds, wid, lane); S.done(cur); }
#undef PG8_SA
#undef PG8_SB
#undef PG8_STAGE
#undef PG8_LDA
#undef PG8_LDB
#undef PG8_MMA
#undef PG8_WAIT_V
#undef PG8_WAIT_L
#undef PG8_BAR
#undef PG8_SCHED
}
}
#define PG8_SP2 true
#define PG8_ALIGN true
#define GAS __attribute__((address_space(1)))
#define LAS __attribute__((address_space(3)))
typedef unsigned short bf16;
typedef unsigned v4u __attribute__((ext_vector_type(4)));
typedef float f32x4 __attribute__((ext_vector_type(4)));
typedef short bf16x8 __attribute__((ext_vector_type(8)));
typedef GAS unsigned gu32;
typedef GAS unsigned long long gu64;
#define RLX_AGENT __ATOMIC_RELAXED, __HIP_MEMORY_SCOPE_AGENT
#define LDS_WAIT() asm volatile("s_waitcnt lgkmcnt(0)" ::: "memory")
#define VM_WAIT() asm volatile("s_waitcnt vmcnt(0)" ::: "memory")
__device__ __forceinline__ unsigned long long rt() { return __builtin_amdgcn_s_memrealtime(); }
__device__ __forceinline__ unsigned f2bf(float f) { unsigned u = __builtin_bit_cast(unsigned, f); return (u + 0x7fffu + ((u >> 16) & 1u)) >> 16; }
typedef float f32x2p_ __attribute__((ext_vector_type(2)));
typedef __bf16 bf16x2p_ __attribute__((ext_vector_type(2)));
__device__ __forceinline__ unsigned pk2(float lo, float hi) { f32x2p_ v = {lo, hi}; bf16x2p_ b = __builtin_convertvector(v, bf16x2p_); return __builtin_bit_cast(unsigned, b); }
#define XB_TMO      128
#define XB_XCNT(j)  (256  + 64 * (j))
#define XB_XSUB(j)  (1280 + 64 * (j))
#define XB_XGEN(j)  (2304 + 64 * (j))
#define XB_TOP      3328
#define XB_TOPGEN   3392
#define XCD_BAR_WORDS 3456
#define XB_SPIN_CAP (1u << 18)

__device__ __forceinline__ unsigned xb_ld(unsigned* p)              { return __hip_atomic_load(p, __ATOMIC_RELAXED, __HIP_MEMORY_SCOPE_AGENT); }
__device__ __forceinline__ unsigned xb_add(unsigned* p, unsigned v) { return __hip_atomic_fetch_add(p, v, __ATOMIC_RELAXED, __HIP_MEMORY_SCOPE_AGENT); }
__device__ __forceinline__ unsigned xb_xcc_id() { return (unsigned)__builtin_amdgcn_s_getreg((3 << 11) | 20) & 0xFu; }
#define XB_SPIN(cond, bar) do { unsigned _sp = 0; while (cond) { __builtin_amdgcn_s_sleep(1); \
    if ((++_sp & 255u) == 0u) { if (xb_ld(&(bar)[XB_TMO])) break; if (_sp > XB_SPIN_CAP) { atomicAdd(&(bar)[XB_TMO], 1u); break; } } } } while (0)

struct XcdBarrier {
    unsigned* bar; unsigned x;
    volatile LAS unsigned* st;
};

__device__ __forceinline__ XcdBarrier xcd_barrier_post(unsigned* bar, volatile LAS unsigned* st) {
    XcdBarrier b; b.bar = bar; b.x = xb_xcc_id(); b.st = st;
    if (threadIdx.x == 0) (void)xb_add(&bar[XB_XCNT(b.x)], 1u);
    return b;
}
__device__ __forceinline__ void xcd_barrier_complete(unsigned* bar, unsigned x, unsigned& nloc, unsigned& nx) {
    const unsigned G = gridDim.x * gridDim.y * gridDim.z;
    unsigned sum, cnt, mine, sp = 0u;
    for (;;) {
        sum = 0u; cnt = 0u; mine = 0u;
#pragma unroll
        for (unsigned j = 0; j < 16; ++j) { const unsigned c = xb_ld(&bar[XB_XCNT(j)]); sum += c; cnt += (c > 0u) ? 1u : 0u; mine = (j == x) ? c : mine; }
        if (sum == G) break;
        __builtin_amdgcn_s_sleep(1);
        if ((++sp & 255u) == 0u) { if (xb_ld(&bar[XB_TMO])) break; if (sp > XB_SPIN_CAP) { atomicAdd(&bar[XB_TMO], 1u); break; } }
    }
    nloc = mine > 0u ? mine : 1u; nx = cnt > 0u ? cnt : 1u;
}

__device__ __forceinline__ void xcd_barrier(const XcdBarrier& b) {
    asm volatile("s_waitcnt vmcnt(0)" ::: "memory");
    __syncthreads();
    if (threadIdx.x == 0) {
        unsigned* bar = b.bar;
        __builtin_amdgcn_s_waitcnt(0);
        unsigned nloc = b.st[0], nx = b.st[1];
        if (nloc == 0u) { xcd_barrier_complete(bar, b.x, nloc, nx); b.st[0] = nloc; b.st[1] = nx; }
        const unsigned old = xb_add(&bar[XB_XSUB(b.x)], 1u);
        const unsigned gen = old / nloc;
        if (old + 1u == (gen + 1u) * nloc) {
            __builtin_amdgcn_fence(__ATOMIC_RELEASE, "agent");
            asm volatile("s_waitcnt vmcnt(0)" ::: "memory");
            const unsigned og = xb_add(&bar[XB_TOP], 1u);
            const unsigned tg = og / nx;
            if (og + 1u == (tg + 1u) * nx) xb_add(&bar[XB_TOPGEN], 1u);
            else XB_SPIN(xb_ld(&bar[XB_TOPGEN]) == tg, bar);
            __builtin_amdgcn_fence(__ATOMIC_ACQUIRE, "agent");
            xb_add(&bar[XB_XGEN(b.x)], 1u);
            asm volatile("s_waitcnt vmcnt(0)" ::: "memory");
        } else {
            XB_SPIN(xb_ld(&bar[XB_XGEN(b.x)]) == gen, bar);
            __builtin_amdgcn_fence(__ATOMIC_ACQUIRE, "agent");
            asm volatile("s_waitcnt vmcnt(0)" ::: "memory");
        }
    }
    __syncthreads();
}
constexpr int NWAVES = 8, NTHR = 512;
constexpr int BATCH = 8, SEQ = 4096, D = 1024, M = BATCH * SEQ, DEPTH = 2;
constexpr int NIN = 6656, NA = 4096, NB = 2560;
constexpr int PA_RQ = 0, PA_RK = 512, PA_RV = 1024, PA_RG = 2048, PA_GA = 3072;
constexpr int PB_AQ = 0, PB_AK = 1024, PB_AV = 1280, PB_GB = 1536;
constexpr int NQP = 2048, NEXP = 16384, MODW = 6144;
constexpr float EPS = 1e-6f;
constexpr int XP = 2048;
constexpr size_t MiB = 1u << 20;
constexpr size_t WS_CTL = 0, CTL_ZERO_BYTES = 1 * MiB;
constexpr size_t WS_MOD = 1 * MiB;
constexpr size_t WS_ROPE_R = 2 * MiB;
constexpr size_t WS_ROPE_A = 10 * MiB;
constexpr size_t WS_WIN = 12 * MiB;
constexpr size_t WS_WOUT = 38 * MiB;
constexpr size_t WS_WQ = 42 * MiB;
constexpr size_t WS_K1 = 50 * MiB;
constexpr size_t WS_K2 = WS_K1 + 512 * 1024;
constexpr size_t WS_XN = 52 * MiB;
constexpr size_t WS_MERGED = 116 * MiB;
constexpr size_t WS_PROJ = 180 * MiB;
constexpr size_t WS_QP = WS_PROJ, WS_IDX = WS_PROJ + 128 * MiB, WS_GATE = WS_PROJ + 144 * MiB;
constexpr size_t WS_U8 = WS_MERGED, WS_V8 = WS_MERGED + 16 * MiB, WS_SU = WS_MERGED + 32 * MiB, WS_SV = WS_MERGED + 33 * MiB;
constexpr size_t WS_PREVT = 436 * MiB;
constexpr size_t WS_END = 468 * MiB;
constexpr int CW_BAR = 4096;
constexpr int SCR_BYTES = 147456;
constexpr int LDSCTL_OFF = SCR_BYTES, LDS_BYTES = SCR_BYTES + 1024;

typedef float f32x2v __attribute__((ext_vector_type(2)));
struct Args { const float* in[17]; float* out; unsigned char* ws; int ph_lo, ph_hi, li, pad; };
__device__ const float INV_R[32] = {1.000000000e+00f, 7.498942614e-01f, 5.623413324e-01f, 4.216965139e-01f, 3.162277639e-01f, 2.371373773e-01f, 1.778279394e-01f, 1.333521307e-01f, 1.000000015e-01f, 7.498941571e-02f, 5.623413250e-02f, 4.216965288e-02f, 3.162277490e-02f, 2.371373773e-02f, 1.778279431e-02f, 1.333521493e-02f, 9.999999776e-03f, 7.498941850e-03f, 5.623413250e-03f, 4.216964822e-03f, 3.162277630e-03f, 2.371373586e-03f, 1.778279431e-03f, 1.333521446e-03f, 1.000000047e-03f, 7.498942432e-04f, 5.623413017e-04f, 4.216965172e-04f, 3.162277571e-04f, 2.371373703e-04f, 1.778279402e-04f, 1.333521504e-04f};
__device__ const float INV_A[8] = {1.000000000e+00f, 1.939227432e-01f, 3.760603070e-02f, 7.292664610e-03f, 1.414213562e-03f, 2.742481884e-04f, 5.318296098e-05f, 1.031338616e-05f};

__device__ __forceinline__ float bflo(unsigned w) { return __builtin_bit_cast(float, w << 16); }
__device__ __forceinline__ float bfhi(unsigned w) { return __builtin_bit_cast(float, w & 0xffff0000u); }
__device__ __forceinline__ float bf2f(unsigned short h) { return __builtin_bit_cast(float, (unsigned)h << 16); }
__device__ __forceinline__ void unpack8(const v4u w, float* f) { f[0] = bflo(w.x); f[1] = bfhi(w.x); f[2] = bflo(w.y); f[3] = bfhi(w.y); f[4] = bflo(w.z); f[5] = bfhi(w.z); f[6] = bflo(w.w); f[7] = bfhi(w.w); }
typedef unsigned v2u_ __attribute__((ext_vector_type(2)));
template <int CTRL> __device__ __forceinline__ float dpp_f(float v) { return __builtin_bit_cast(float, __builtin_amdgcn_update_dpp(0, __builtin_bit_cast(int, v), CTRL, 0xf, 0xf, true)); }
__device__ __forceinline__ void swap16_(float v, float& a, float& b) { const v2u_ s = __builtin_amdgcn_permlane16_swap(__builtin_bit_cast(unsigned, v), __builtin_bit_cast(unsigned, v), false, false); const unsigned a_ = s.x, b_ = s.y; a = __builtin_bit_cast(float, a_); b = __builtin_bit_cast(float, b_); }
__device__ __forceinline__ void swap32_(float v, float& a, float& b) { const v2u_ s = __builtin_amdgcn_permlane32_swap(__builtin_bit_cast(unsigned, v), __builtin_bit_cast(unsigned, v), false, false); const unsigned a_ = s.x, b_ = s.y; a = __builtin_bit_cast(float, a_); b = __builtin_bit_cast(float, b_); }
__device__ __forceinline__ float wave_sum(float v) {
    v += dpp_f<0xB1>(v); v += dpp_f<0x4E>(v); v += dpp_f<0x141>(v); v += dpp_f<0x140>(v);
    float a, b; swap16_(v, a, b); v = a + b; swap32_(v, a, b); return a + b;
}
__device__ __forceinline__ float wave_max(float v) {
    v = fmaxf(v, dpp_f<0xB1>(v)); v = fmaxf(v, dpp_f<0x4E>(v)); v = fmaxf(v, dpp_f<0x141>(v)); v = fmaxf(v, dpp_f<0x140>(v));
    float a, b; swap16_(v, a, b); v = fmaxf(a, b); swap32_(v, a, b); return fmaxf(a, b);
}
#define LDS_BARRIER() do { asm volatile("s_waitcnt lgkmcnt(0)" ::: "memory"); __builtin_amdgcn_s_barrier(); asm volatile("" ::: "memory"); } while (0)
__device__ __forceinline__ float sigmoidf_(float x) { return __builtin_amdgcn_rcpf(1.f + __expf(-x)); }
__device__ __forceinline__ float siluf_(float x) { return x * __builtin_amdgcn_rcpf(1.f + __expf(-x)); }
__device__ __forceinline__ float rl_f(float v, int k) { return __builtin_bit_cast(float, __builtin_amdgcn_readlane(__builtin_bit_cast(int, v), k)); }
__device__ __forceinline__ int rl_i(int v, int k) { return __builtin_amdgcn_readlane(v, k); }

__device__ __forceinline__ void p0_transpose_item(const float* W, int K, int N, bf16* WT, int mode, LAS float* scr, int item, int lane) {
    const int nblk = N / 32, kb = item / nblk, nb = item % nblk, k0 = 64 * kb, n0 = 32 * nb;
    int d0 = n0;
    if (mode == 1) { if (n0 >= 3072 && n0 < 4608) d0 = n0 + 1024; else if (n0 >= 4608 && n0 < 5632) d0 = n0 - 1536; }
#pragma unroll 8
    for (int i = 0; i < 32; ++i) { const int kk = 2 * i + (lane >> 5); scr[kk * 33 + (lane & 31)] = W[(size_t)(k0 + kk) * N + n0 + (lane & 31)]; }
    LDS_WAIT(); asm volatile("" ::: "memory");
    const int c = lane & 7;
#pragma unroll
    for (int j = 0; j < 4; ++j) { const int n = (lane >> 3) + 8 * j; const LAS float* s = scr + (8 * c) * 33 + n;
        v4u o; o.x = pk2(s[0 * 33], s[1 * 33]); o.y = pk2(s[2 * 33], s[3 * 33]); o.z = pk2(s[4 * 33], s[5 * 33]); o.w = pk2(s[6 * 33], s[7 * 33]);
        *(GAS v4u*)(WT + (size_t)(d0 + n) * K + k0 + 8 * c) = o; }
    LDS_WAIT(); asm volatile("" ::: "memory");
}
__device__ __forceinline__ void cvt_f32_bf16(const float* src, bf16* dst, size_t n8, size_t g0, size_t gstride) {
    for (size_t i = g0; i < n8; i += gstride) { const f32x4 a = *(const GAS f32x4*)(src + i * 8), b = *(const GAS f32x4*)(src + i * 8 + 4);
        v4u o; o.x = pk2(a.x, a.y); o.y = pk2(a.z, a.w); o.z = pk2(b.x, b.y); o.w = pk2(b.z, b.w); *(GAS v4u*)(dst + i * 8) = o; }
}
__device__ __forceinline__ void phase_prologue(const Args& a, LAS unsigned char* lds, int vcu, int G, int tid) {
    const int lane = tid & 63, wave = __builtin_amdgcn_readfirstlane(tid >> 6);
    unsigned char* ws = a.ws;
    if (vcu < 192) {
        LAS float* cond = (LAS float*)lds; LAS float* red = (LAS float*)(lds + 32768);
        const float* c = a.in[1];
        for (int i = tid; i < BATCH * D; i += NTHR) { const float v = c[i]; cond[i] = v / (1.f + expf(-v)); }
        __syncthreads();
        const int l = vcu / 96, j0 = (vcu % 96) * 64, col = tid & 63, ks = tid >> 6;
        const float* W = a.in[3] + (size_t)l * D * MODW + j0 + col;
        float acc[8];
#pragma unroll
        for (int b = 0; b < 8; ++b) acc[b] = 0.f;
        for (int k = ks * 128; k < ks * 128 + 128; ++k) { const float w = W[(size_t)k * MODW];
#pragma unroll
            for (int b = 0; b < 8; ++b) acc[b] += cond[b * D + k] * w; }
#pragma unroll
        for (int b = 0; b < 8; ++b) red[(ks * 8 + b) * 64 + col] = acc[b];
        __syncthreads();
        { const int b = tid >> 6; float s = 0.f;
#pragma unroll
          for (int k2 = 0; k2 < 8; ++k2) s += red[(k2 * 8 + b) * 64 + col];
          s += a.in[4][l * MODW + j0 + col];
          ((float*)(ws + WS_MOD))[(size_t)(l * 8 + b) * MODW + j0 + col] = s; }
        __syncthreads();
    }
    {
        LAS float* scr = (LAS float*)(lds + 49152 + wave * 8448);
        const int gw = vcu * NWAVES + wave, NGW = G * NWAVES;
        constexpr int I_IN = (D / 64) * (NIN / 32), I_OUT = (D / 64) * (D / 32), I_Q = (D / 64) * (NQP / 32), I_L = I_IN + I_OUT + I_Q;
        for (int it = gw; it < 2 * I_L; it += NGW) {
            const int l = it / I_L; int r = it % I_L;
            if (r < I_IN) { p0_transpose_item(a.in[7] + (size_t)l * D * NIN, D, NIN, (bf16*)(ws + WS_WIN) + (size_t)l * NIN * D, 1, scr, r, lane); continue; } r -= I_IN;
            if (r < I_OUT) { p0_transpose_item(a.in[10] + (size_t)l * D * D, D, D, (bf16*)(ws + WS_WOUT) + (size_t)l * D * D, 0, scr, r, lane); continue; } r -= I_OUT;
            p0_transpose_item(a.in[11] + (size_t)l * D * NQP, D, NQP, (bf16*)(ws + WS_WQ) + (size_t)l * NQP * D, 0, scr, r, lane);
        }
    }
    const size_t gt = (size_t)vcu * NTHR + tid, GT = (size_t)G * NTHR;
    cvt_f32_bf16(a.in[12], (bf16*)(ws + WS_K1), (size_t)2 * 8 * 128 * 128 / 8, gt, GT);
    cvt_f32_bf16(a.in[13], (bf16*)(ws + WS_K2), (size_t)2 * 8 * 128 * 128 / 8, gt, GT);
    {
        const int* pos = (const int*)a.in[2];
        unsigned* tr = (unsigned*)(ws + WS_ROPE_R); unsigned* ta = (unsigned*)(ws + WS_ROPE_A);
        for (size_t idx = gt; idx < (size_t)M * 32; idx += GT) { const int m = (int)(idx >> 5), i = (int)(idx & 31);
            const float ang = (float)pos[m] * INV_R[i]; const double t = (double)ang * 0.15915494309189535; const float r = (float)(t - rint(t));
            tr[idx] = pk2(__builtin_amdgcn_cosf(r), __builtin_amdgcn_sinf(r)); }
        for (size_t idx = gt; idx < (size_t)M * 8; idx += GT) { const int m = (int)(idx >> 3), i = (int)(idx & 7);
            const float ang = (float)pos[m] * INV_A[i]; const double t = (double)ang * 0.15915494309189535; const float r = (float)(t - rint(t));
            ta[idx] = pk2(__builtin_amdgcn_cosf(r), __builtin_amdgcn_sinf(r)); }
    }
}

__device__ __forceinline__ void phase_norm(const float* x, const float* g, const float* mod_sc, const float* mod_sh, bf16* xn, int vcu, int G, int tid) {
    const int lane = tid & 63, wave = __builtin_amdgcn_readfirstlane(tid >> 6);
    const int gw = vcu * NWAVES + wave, NGW = G * NWAVES;
    constexpr int RI = 4;
    f32x4 gg[4];
#pragma unroll
    for (int j = 0; j < 4; ++j) gg[j] = ((const GAS f32x4*)g)[lane + 64 * j];
    for (int m0 = gw; m0 < M; m0 += NGW * RI) {
        f32x4 v[RI][4]; float s[RI];
#pragma unroll
        for (int r = 0; r < RI; ++r) { const int m = m0 + r * NGW; const GAS f32x4* xr = (const GAS f32x4*)(x + (size_t)(m < M ? m : gw) * D) + lane;
#pragma unroll
            for (int j = 0; j < 4; ++j) v[r][j] = xr[64 * j]; }
#pragma unroll
        for (int r = 0; r < RI; ++r) { float a = 0.f;
#pragma unroll
            for (int j = 0; j < 4; ++j) a += (v[r][j].x * v[r][j].x + v[r][j].y * v[r][j].y) + (v[r][j].z * v[r][j].z + v[r][j].w * v[r][j].w);
            s[r] = a; }
#pragma unroll
        for (int r = 0; r < RI; ++r) s[r] = wave_sum(s[r]);
#pragma unroll
        for (int r = 0; r < RI; ++r) { const int m = m0 + r * NGW; const int mc = m < M ? m : gw; const int b = mc >> 12; const float rstd = rsqrtf(s[r] * (1.f / D) + EPS);
            const float* sc = mod_sc + (size_t)b * MODW; const float* sh = mod_sh + (size_t)b * MODW;
            f32x4 cc[4], hh[4];
#pragma unroll
            for (int j = 0; j < 4; ++j) { cc[j] = ((const GAS f32x4*)sc)[lane + 64 * j]; hh[j] = ((const GAS f32x4*)sh)[lane + 64 * j]; }
            asm volatile("" ::: "memory");
            if (m < M) { GAS unsigned long long* o8 = (GAS unsigned long long*)(xn + (size_t)m * D) + lane;
#pragma unroll
                for (int j = 0; j < 4; ++j) { const f32x4 y = (v[r][j] * rstd * gg[j]) * (cc[j] + 1.0f) + hh[j];
                    o8[64 * j] = (unsigned long long)pk2(y.x, y.y) | ((unsigned long long)pk2(y.z, y.w) << 32); } } }
    }
}
__device__ __forceinline__ void phase_norm_b(const bf16* x, const float* g, const float* mod_sc, const float* mod_sh, bf16* xn, int vcu, int G, int tid) {
    const int lane = tid & 63, wave = __builtin_amdgcn_readfirstlane(tid >> 6);
    const int gw = vcu * NWAVES + wave, NGW = G * NWAVES;
    constexpr int RI = 4;
    f32x4 gg[2][2];
#pragma unroll
    for (int j = 0; j < 2; ++j)
#pragma unroll
        for (int q = 0; q < 2; ++q) gg[j][q] = *(const GAS f32x4*)(g + 8 * (lane + 64 * j) + 4 * q);
    for (int m0 = gw; m0 < M; m0 += NGW * RI) {
        v4u v[RI][2]; float s[RI];
#pragma unroll
        for (int r = 0; r < RI; ++r) { const int m = m0 + r * NGW; const GAS v4u* xr = (const GAS v4u*)(x + (size_t)(m < M ? m : gw) * XP) + lane; v[r][0] = xr[0]; v[r][1] = xr[64]; }
#pragma unroll
        for (int r = 0; r < RI; ++r) { float f[16]; unpack8(v[r][0], f); unpack8(v[r][1], f + 8); float a = 0.f;
#pragma unroll
            for (int j = 0; j < 16; j += 4) a += (f[j] * f[j] + f[j + 1] * f[j + 1]) + (f[j + 2] * f[j + 2] + f[j + 3] * f[j + 3]);
            s[r] = a; }
#pragma unroll
        for (int r = 0; r < RI; ++r) s[r] = wave_sum(s[r]);
#pragma unroll
        for (int r = 0; r < RI; ++r) { const int m = m0 + r * NGW; const int mc = m < M ? m : gw; const int b = mc >> 12; const float rstd = rsqrtf(s[r] * (1.f / D) + EPS);
            const float* sc = mod_sc + (size_t)b * MODW; const float* sh = mod_sh + (size_t)b * MODW;
            f32x4 cc[2][2], hh[2][2];
#pragma unroll
            for (int j = 0; j < 2; ++j)
#pragma unroll
                for (int q = 0; q < 2; ++q) { cc[j][q] = *(const GAS f32x4*)(sc + 8 * (lane + 64 * j) + 4 * q); hh[j][q] = *(const GAS f32x4*)(sh + 8 * (lane + 64 * j) + 4 * q); }
            asm volatile("" ::: "memory");
            if (m < M) {
#pragma unroll
                for (int j = 0; j < 2; ++j) { const int c0 = 8 * (lane + 64 * j); float f[8]; unpack8(v[r][j], f); unsigned pk[4];
#pragma unroll
                    for (int q = 0; q < 2; ++q) { const f32x4 xv = (f32x4){f[4 * q], f[4 * q + 1], f[4 * q + 2], f[4 * q + 3]};
                        const f32x4 y = (xv * rstd * gg[j][q]) * (cc[j][q] + 1.0f) + hh[j][q]; pk[2 * q] = pk2(y.x, y.y); pk[2 * q + 1] = pk2(y.z, y.w); }
                    *(GAS v4u*)(xn + (size_t)m * D + c0) = (v4u){pk[0], pk[1], pk[2], pk[3]}; } } }
    }
}

__device__ __forceinline__ float ret_log2g(int h) { return log2f(1.f - exp2f(-5.f - (float)h)); }
typedef float f32x16v_ __attribute__((ext_vector_type(16)));
typedef short bf16x8v_ __attribute__((ext_vector_type(8)));
typedef __bf16 bf16x2_t_ __attribute__((ext_vector_type(2)));
__device__ __forceinline__ unsigned cvtpk_(float lo, float hi) { f32x2v v = {lo, hi}; bf16x2_t_ b = __builtin_convertvector(v, bf16x2_t_); return __builtin_bit_cast(unsigned, b); }
__device__ __forceinline__ int mrow(int r, int h5) { return (r & 3) + 8 * (r >> 2) + 4 * h5; }
__device__ __forceinline__ void phase_swa_mfma(const bf16* projB, const unsigned* ropeA, const float* sinks, bf16* merged, LAS unsigned char* lds, int vcu, int G, int tid) {
    const int lane = tid & 63, wave = __builtin_amdgcn_readfirstlane(tid >> 6), h5 = lane >> 5, l31 = lane & 31;
    LAS unsigned short* Ks = (LAS unsigned short*)lds;
    LAS unsigned short* Vt = (LAS unsigned short*)(lds + 36864);
    const float L2E = 1.4426950408889634f;
    const int frow = tid >> 1, fhalf = tid & 1;
    v4u kw[4], vw[4], kcs[2];
#define SWA_LOAD(uu) do { const int kvh_ = (uu) & 3, n_ = ((uu) >> 2) & 31, b_ = (uu) >> 7; int tok_ = b_ * SEQ + n_ * 128 - 128 + frow; tok_ = (n_ > 0 || frow >= 128) ? tok_ : b_ * SEQ + frow; \
        const bf16* kp_ = projB + (size_t)tok_ * NB + PB_AK + kvh_ * 64 + fhalf * 32; const bf16* vp_ = projB + (size_t)tok_ * NB + PB_AV + kvh_ * 64 + fhalf * 32; \
        _Pragma("unroll") for (int i = 0; i < 4; ++i) { kw[i] = *(const GAS v4u*)(kp_ + 8 * i); vw[i] = *(const GAS v4u*)(vp_ + 8 * i); } \
        kcs[0] = *(const GAS v4u*)(ropeA + (size_t)tok_ * 8); kcs[1] = *(const GAS v4u*)(ropeA + (size_t)tok_ * 8 + 4); } while (0)
    if (vcu < 1024) SWA_LOAD(vcu);
    for (int u = vcu; u < 1024; u += G) {
        const int kvh = u & 3, n = (u >> 2) & 31, b = u >> 7; const int tok0 = b * SEQ + n * 128;
        const int a = kvh * 4 + (wave >> 1);
        v4u qraw[2][4]; v4u qcs[2][2];
#pragma unroll
        for (int i = 0; i < 2; ++i) { const size_t token = (size_t)tok0 + (wave & 1) * 64 + 32 * i + l31; const bf16* qp = projB + token * NB + PB_AQ + a * 64 + 8 * h5;
#pragma unroll
            for (int s_ = 0; s_ < 4; ++s_) qraw[i][s_] = *(const GAS v4u*)(qp + 16 * s_);
            qcs[i][0] = *(const GAS v4u*)(ropeA + token * 8); qcs[i][1] = *(const GAS v4u*)(ropeA + token * 8 + 4); }
        {
            const int row = frow, half = fhalf; const bool valid = (n > 0) || (row >= 128);
            if (half == 0) { float t1[8], t2[8]; unpack8(kw[0], t1); unpack8(kw[1], t2); float o1[8], o2[8];
#pragma unroll
                for (int j = 0; j < 8; ++j) { const unsigned cw_ = kcs[j >> 2][j & 3]; const float cc = bflo(cw_), ss = bfhi(cw_); o1[j] = t1[j] * cc - t2[j] * ss; o2[j] = t2[j] * cc + t1[j] * ss; }
                kw[0] = (v4u){cvtpk_(o1[0], o1[1]), cvtpk_(o1[2], o1[3]), cvtpk_(o1[4], o1[5]), cvtpk_(o1[6], o1[7])};
                kw[1] = (v4u){cvtpk_(o2[0], o2[1]), cvtpk_(o2[2], o2[3]), cvtpk_(o2[4], o2[5]), cvtpk_(o2[6], o2[7])}; }
            const unsigned vm_ = valid ? 0xffffffffu : 0u;
#pragma unroll
            for (int i = 0; i < 4; ++i) *(LAS v4u*)(Ks + row * 72 + half * 32 + 8 * i) = (v4u){kw[i].x & vm_, kw[i].y & vm_, kw[i].z & vm_, kw[i].w & vm_};
#pragma unroll
            for (int i = 0; i < 4; ++i)
#pragma unroll
                for (int j = 0; j < 4; ++j) { const unsigned w = vw[i][j] & vm_; Vt[(half * 32 + 8 * i + 2 * j) * 260 + row] = (unsigned short)(w & 0xffffu); Vt[(half * 32 + 8 * i + 2 * j + 1) * 260 + row] = (unsigned short)(w >> 16); }
        }
        LDS_BARRIER();
        if (u + G < 1024) SWA_LOAD(u + G);
        const float sink = sinks[a];
#pragma unroll
        for (int i = 0; i < 2; ++i) {
            const int q0 = (wave & 1) * 64 + 32 * i, kt0 = q0 >> 5; const size_t token = (size_t)tok0 + q0 + l31;
            bf16x8v_ qf[4];
            { v4u qw[4];
#pragma unroll
              for (int s_ = 0; s_ < 4; ++s_) qw[s_] = qraw[i][s_];
              v4u pw;
#pragma unroll
              for (int j = 0; j < 4; ++j) pw[j] = (unsigned)__shfl_xor((int)qw[0][j], 32);
              float own[8], oth[8]; unpack8(qw[0], own); unpack8(pw, oth); float o[8];
#pragma unroll
              for (int j = 0; j < 8; ++j) { const unsigned cw_ = qcs[i][j >> 2][j & 3]; const f32x2v c = (f32x2v){bflo(cw_), bfhi(cw_)}; const float ow_ = own[j], ot_ = oth[j]; const float t1 = h5 ? ot_ : ow_, t2 = h5 ? ow_ : ot_; o[j] = (h5 ? (t2 * c.x + t1 * c.y) : (t1 * c.x - t2 * c.y)) * 0.125f; }
              qw[0] = (v4u){cvtpk_(o[0], o[1]), cvtpk_(o[2], o[3]), cvtpk_(o[4], o[5]), cvtpk_(o[6], o[7])};
#pragma unroll
              for (int s_ = 1; s_ < 4; ++s_) { float f[8]; unpack8(qw[s_], f); qw[s_] = (v4u){cvtpk_(f[0] * 0.125f, f[1] * 0.125f), cvtpk_(f[2] * 0.125f, f[3] * 0.125f), cvtpk_(f[4] * 0.125f, f[5] * 0.125f), cvtpk_(f[6] * 0.125f, f[7] * 0.125f)}; }
#pragma unroll
              for (int s_ = 0; s_ < 4; ++s_) qf[s_] = __builtin_bit_cast(bf16x8v_, qw[s_]); }
            f32x16v_ sacc[5];
#pragma unroll
            for (int jt = 0; jt < 5; ++jt) {
#pragma unroll
                for (int r = 0; r < 16; ++r) sacc[jt][r] = 0.f;
#pragma unroll
                for (int s_ = 0; s_ < 4; ++s_) { const bf16x8v_ kf = *(const LAS bf16x8v_*)(Ks + (32 * (kt0 + jt) + l31) * 72 + 16 * s_ + 8 * h5); sacc[jt] = __builtin_amdgcn_mfma_f32_32x32x16_bf16(kf, qf[s_], sacc[jt], 0, 0, 0); }
            }
            v4u gwv[4];
#pragma unroll
            for (int i2 = 0; i2 < 4; ++i2) gwv[i2] = *(const GAS v4u*)(projB + token * NB + PB_GB + a * 64 + 32 * h5 + 8 * i2);
            float mx = -1e30f;
#pragma unroll
            for (int jt = 0; jt < 5; ++jt) { const bool tile_ok = (n > 0) || (kt0 + jt >= 4);
#pragma unroll
                for (int r = 0; r < 16; ++r) { const int kl = mrow(r, h5); bool ok = tile_ok; if (jt == 0) ok = ok && (kl > l31); if (jt == 4) ok = ok && (kl <= l31);
                    const float sv_ = ok ? sacc[jt][r] : -1e30f; sacc[jt][r] = sv_; mx = fmaxf(mx, sv_); } }
            mx = fmaxf(mx, __shfl_xor(mx, 32)); mx = fmaxf(mx, sink);
            float sm = 0.f; const float mxl = -mx * L2E;
#pragma unroll
            for (int jt = 0; jt < 5; ++jt)
#pragma unroll
                for (int r = 0; r < 16; ++r) { const float p = __builtin_amdgcn_exp2f(fmaf(sacc[jt][r], L2E, mxl)); sacc[jt][r] = p; sm += p; }
            sm += __shfl_xor(sm, 32);
            const float inv = __builtin_amdgcn_rcpf(sm + __builtin_amdgcn_exp2f(fmaf(sink, L2E, mxl)));
            f32x16v_ oacc[2];
#pragma unroll
            for (int dt = 0; dt < 2; ++dt)
#pragma unroll
                for (int r = 0; r < 16; ++r) oacc[dt][r] = 0.f;
#pragma unroll
            for (int jt = 0; jt < 5; ++jt)
#pragma unroll
                for (int s2 = 0; s2 < 2; ++s2) {
                    const v4u pw = (v4u){cvtpk_(sacc[jt][8 * s2 + 0], sacc[jt][8 * s2 + 1]), cvtpk_(sacc[jt][8 * s2 + 2], sacc[jt][8 * s2 + 3]), cvtpk_(sacc[jt][8 * s2 + 4], sacc[jt][8 * s2 + 5]), cvtpk_(sacc[jt][8 * s2 + 6], sacc[jt][8 * s2 + 7])};
                    const bf16x8v_ pf = __builtin_bit_cast(bf16x8v_, pw);
#pragma unroll
                    for (int dt = 0; dt < 2; ++dt) { const LAS unsigned short* vp_ = Vt + (32 * dt + l31) * 260 + 32 * (kt0 + jt) + 16 * s2 + 4 * h5;
                        const unsigned long long lo = *(const LAS unsigned long long*)vp_, hi = *(const LAS unsigned long long*)(vp_ + 8);
                        const v4u aw = (v4u){(unsigned)lo, (unsigned)(lo >> 32), (unsigned)hi, (unsigned)(hi >> 32)};
                        oacc[dt] = __builtin_amdgcn_mfma_f32_32x32x16_bf16(__builtin_bit_cast(bf16x8v_, aw), pf, oacc[dt], 0, 0, 0); }
                }
            { LAS float* Ow = (LAS float*)(lds + 70144) + wave * (32 * 68);
#pragma unroll
              for (int dt = 0; dt < 2; ++dt)
#pragma unroll
                  for (int g_ = 0; g_ < 4; ++g_) *(LAS f32x4*)(Ow + l31 * 68 + 32 * dt + 8 * g_ + 4 * h5) = (f32x4){oacc[dt][4 * g_ + 0] * inv, oacc[dt][4 * g_ + 1] * inv, oacc[dt][4 * g_ + 2] * inv, oacc[dt][4 * g_ + 3] * inv};
              asm volatile("s_waitcnt lgkmcnt(0)" ::: "memory");
              bf16* mp = merged + token * D + a * 64 + 32 * h5;
#pragma unroll
              for (int i2 = 0; i2 < 4; ++i2) { const f32x4 oa = *(const LAS f32x4*)(Ow + l31 * 68 + 32 * h5 + 8 * i2), ob = *(const LAS f32x4*)(Ow + l31 * 68 + 32 * h5 + 8 * i2 + 4);
                  float gf[8]; unpack8(gwv[i2], gf);
                  *(GAS v4u*)(mp + 8 * i2) = (v4u){cvtpk_(oa[0] * sigmoidf_(gf[0]), oa[1] * sigmoidf_(gf[1])), cvtpk_(oa[2] * sigmoidf_(gf[2]), oa[3] * sigmoidf_(gf[3])),
                                                   cvtpk_(ob[0] * sigmoidf_(gf[4]), ob[1] * sigmoidf_(gf[5])), cvtpk_(ob[2] * sigmoidf_(gf[6]), ob[3] * sigmoidf_(gf[7]))}; }
              asm volatile("s_waitcnt lgkmcnt(0)" ::: "memory"); }
        }
        LDS_BARRIER();
    }
#undef SWA_LOAD
}


typedef short v4i16_ __attribute__((ext_vector_type(4)));
__device__ __forceinline__ v4i16_ lds_tr4(const LAS unsigned short* p) { return __builtin_amdgcn_ds_read_tr16_b64_v4i16((LAS v4i16_*)p); }
__device__ __forceinline__ void phase_ret_kv_mfma(const bf16* projA, const unsigned* ropeR, float* KVT, LAS unsigned char* lds, int vcu, int G, int tid) {
    const int lane = tid & 63, wave = __builtin_amdgcn_readfirstlane(tid >> 6), h5 = lane >> 5, l31 = lane & 31;
    LAS unsigned short* Kr = (LAS unsigned short*)lds;
    LAS unsigned short* Vr = (LAS unsigned short*)(lds + 24576);
    const int m = tid >> 2, seg = tid & 3, i0 = seg * 8;
    v4u wa, wb, vw[4], cs[2];
#define R1_LOAD(uu) do { const int n_ = (uu) & 31, h_ = ((uu) >> 5) & 7, b_ = (uu) >> 8; const size_t tok_ = (size_t)b_ * SEQ + n_ * 128 + m; \
        const bf16* kp_ = projA + tok_ * NA + PA_RK + h_ * 64; wa = *(const GAS v4u*)(kp_ + i0); wb = *(const GAS v4u*)(kp_ + i0 + 32); \
        cs[0] = *(const GAS v4u*)(ropeR + tok_ * 32 + i0); cs[1] = *(const GAS v4u*)(ropeR + tok_ * 32 + i0 + 4); \
        const bf16* vp_ = projA + tok_ * NA + PA_RV + h_ * 128 + seg * 32; _Pragma("unroll") for (int i = 0; i < 4; ++i) vw[i] = *(const GAS v4u*)(vp_ + 8 * i); } while (0)
    if (vcu < 2048) R1_LOAD(vcu);
    const int trq = (lane & 15) >> 2, trp = lane & 3, trg = (lane >> 4) & 1;
    for (int u = vcu; u < 2048; u += G) {
        const int h = (u >> 5) & 7; const float l2g = ret_log2g(h);
        { float t1[8], t2[8]; unpack8(wa, t1); unpack8(wb, t2); const float w = 0.125f * __builtin_amdgcn_exp2f((float)(127 - m) * l2g); float o1[8], o2[8];
#pragma unroll
          for (int j = 0; j < 8; ++j) { const unsigned cw_ = cs[j >> 2][j & 3]; const f32x2v c = (f32x2v){bflo(cw_), bfhi(cw_)}; o1[j] = (t1[j] * c.x - t2[j] * c.y) * w; o2[j] = (t2[j] * c.x + t1[j] * c.y) * w; }
          *(LAS v4u*)(Kr + m * 96 + i0) = (v4u){cvtpk_(o1[0], o1[1]), cvtpk_(o1[2], o1[3]), cvtpk_(o1[4], o1[5]), cvtpk_(o1[6], o1[7])};
          *(LAS v4u*)(Kr + m * 96 + i0 + 32) = (v4u){cvtpk_(o2[0], o2[1]), cvtpk_(o2[2], o2[3]), cvtpk_(o2[4], o2[5]), cvtpk_(o2[6], o2[7])};
#pragma unroll
          for (int i = 0; i < 4; ++i) *(LAS v4u*)(Vr + m * 160 + seg * 32 + 8 * i) = vw[i]; }
        LDS_BARRIER();
        if (u + G < 2048) R1_LOAD(u + G);
        const int dvt = wave >> 1, dkt = wave & 1;
        f32x16v_ acc;
#pragma unroll
        for (int r = 0; r < 16; ++r) acc[r] = 0.f;
        const LAS unsigned short* va = Vr + (8 * h5 + trq) * 160 + 32 * dvt + 16 * trg + 4 * trp;
        const LAS unsigned short* ka = Kr + (8 * h5 + trq) * 96 + 32 * dkt + 16 * trg + 4 * trp;
#pragma unroll
        for (int s_ = 0; s_ < 8; ++s_) { const v4i16_ a0 = lds_tr4(va + 16 * s_ * 160), a1 = lds_tr4(va + (16 * s_ + 4) * 160), b0 = lds_tr4(ka + 16 * s_ * 96), b1 = lds_tr4(ka + (16 * s_ + 4) * 96);
            const bf16x8v_ af = (bf16x8v_){a0[0], a0[1], a0[2], a0[3], a1[0], a1[1], a1[2], a1[3]}, bfr = (bf16x8v_){b0[0], b0[1], b0[2], b0[3], b1[0], b1[1], b1[2], b1[3]};
            acc = __builtin_amdgcn_mfma_f32_32x32x16_bf16(af, bfr, acc, 0, 0, 0); }
        bf16* op = (bf16*)KVT + (size_t)u * 8192 + 32 * dkt + l31;
#pragma unroll
        for (int r = 0; r < 16; ++r) { const float v_ = acc[r]; const float nb_ = dpp_f<0xB1>(v_); if ((lane & 1) == 0) *(GAS unsigned*)(op + (size_t)(32 * dvt + mrow(r, h5)) * 64) = pk2(v_, nb_); }
        LDS_BARRIER();
    }
#undef R1_LOAD
}
__device__ __forceinline__ void phase_ret_scan2(const float* KVT, bf16* PREVT, int vcu, int G, int tid) {
    const size_t gt = (size_t)vcu * NTHR + tid, GT_ = (size_t)G * NTHR;
    const unsigned* KVb = (const unsigned*)KVT;
    for (size_t idx = gt; idx < (size_t)64 * 4096; idx += GT_) { const int bh = (int)(idx >> 12), pr = (int)(idx & 4095), h = bh & 7;
        const float cd = exp2f(128.f * ret_log2g(h)); f32x2v st = (f32x2v){0.f, 0.f}; unsigned kv[32];
#pragma unroll
        for (int n = 0; n < 32; ++n) kv[n] = KVb[(size_t)(bh * 32 + n) * 4096 + pr];
#pragma unroll
        for (int n = 0; n < 32; ++n) { *(GAS unsigned*)(PREVT + (size_t)(bh * 32 + n) * 8192 + 2 * pr) = pk2(st.x, st.y); st = st * cd + (f32x2v){bflo(kv[n]), bfhi(kv[n])}; } }
}
__device__ __forceinline__ void phase_ret_out_mfma(const bf16* projA, const unsigned* ropeR, const bf16* PREVT, const float* gn_g, bf16* merged, LAS unsigned char* lds, int vcu, int G, int tid) {
    const int lane = tid & 63, wave = __builtin_amdgcn_readfirstlane(tid >> 6), h5 = lane >> 5, l31 = lane & 31;
    LAS unsigned short* Ks = (LAS unsigned short*)lds;
    LAS unsigned short* Vt = (LAS unsigned short*)(lds + 18432);
    LAS unsigned short* St = (LAS unsigned short*)(lds + 52224);
    LAS float* Xs = (LAS float*)(lds + 70656);
    const int m = tid >> 2, seg = tid & 3, i0 = seg * 8;
    v4u wa, wb, vw[4], pvw[2], fcs[2];
#define R3_LOAD(uu) do { const int n_ = (uu) & 31, h_ = ((uu) >> 5) & 7, b_ = (uu) >> 8; const size_t tok_ = (size_t)b_ * SEQ + n_ * 128 + m; \
        const bf16* kp_ = projA + tok_ * NA + PA_RK + h_ * 64; wa = *(const GAS v4u*)(kp_ + i0); wb = *(const GAS v4u*)(kp_ + i0 + 32); \
        fcs[0] = *(const GAS v4u*)(ropeR + tok_ * 32 + i0); fcs[1] = *(const GAS v4u*)(ropeR + tok_ * 32 + i0 + 4); \
        const bf16* vp_ = projA + tok_ * NA + PA_RV + h_ * 128 + seg * 32; _Pragma("unroll") for (int i = 0; i < 4; ++i) vw[i] = *(const GAS v4u*)(vp_ + 8 * i); \
        _Pragma("unroll") for (int i = 0; i < 2; ++i) { const int idx_ = tid + NTHR * i; pvw[i] = *(const GAS v4u*)(PREVT + (size_t)(uu) * 8192 + (idx_ >> 3) * 64 + 8 * (idx_ & 7)); } } while (0)
    if (vcu < 2048) R3_LOAD(vcu);
    for (int u = vcu; u < 2048; u += G) {
        const int n = u & 31, h = (u >> 5) & 7, b = u >> 8; const int tok0 = b * SEQ + n * 128; const float l2g = ret_log2g(h);
        const int ct = wave & 3, dvh = wave >> 2; const size_t token = (size_t)tok0 + 32 * ct + l31;
        v4u qraw[4]; v4u qcs[2][2];
        { const bf16* qp = projA + token * NA + PA_RQ + h * 64 + 8 * h5;
#pragma unroll
          for (int s_ = 0; s_ < 4; ++s_) qraw[s_] = *(const GAS v4u*)(qp + 16 * s_);
#pragma unroll
          for (int s_ = 0; s_ < 2; ++s_) { qcs[s_][0] = *(const GAS v4u*)(ropeR + token * 32 + 16 * s_ + 8 * h5); qcs[s_][1] = *(const GAS v4u*)(ropeR + token * 32 + 16 * s_ + 8 * h5 + 4); } }
        { float t1[8], t2[8]; unpack8(wa, t1); unpack8(wb, t2); float o1[8], o2[8];
#pragma unroll
          for (int j = 0; j < 8; ++j) { const unsigned cw_ = fcs[j >> 2][j & 3]; const f32x2v c = (f32x2v){bflo(cw_), bfhi(cw_)}; o1[j] = (t1[j] * c.x - t2[j] * c.y) * 0.125f; o2[j] = (t2[j] * c.x + t1[j] * c.y) * 0.125f; }
          *(LAS v4u*)(Ks + m * 72 + i0) = (v4u){cvtpk_(o1[0], o1[1]), cvtpk_(o1[2], o1[3]), cvtpk_(o1[4], o1[5]), cvtpk_(o1[6], o1[7])};
          *(LAS v4u*)(Ks + m * 72 + i0 + 32) = (v4u){cvtpk_(o2[0], o2[1]), cvtpk_(o2[2], o2[3]), cvtpk_(o2[4], o2[5]), cvtpk_(o2[6], o2[7])};
#pragma unroll
          for (int i = 0; i < 4; ++i)
#pragma unroll
              for (int j = 0; j < 4; ++j) { const unsigned wv_ = vw[i][j]; Vt[(seg * 32 + 8 * i + 2 * j) * 132 + m] = (unsigned short)(wv_ & 0xffffu); Vt[(seg * 32 + 8 * i + 2 * j + 1) * 132 + m] = (unsigned short)(wv_ >> 16); }
#pragma unroll
          for (int i = 0; i < 2; ++i) { const int idx = tid + NTHR * i, row = idx >> 3, c8 = idx & 7; *(LAS v4u*)(St + row * 72 + 8 * c8) = pvw[i]; } }
        LDS_BARRIER();
        if (u + G < 2048) R3_LOAD(u + G);
        bf16x8v_ qf[4];
        {
#pragma unroll
          for (int s_ = 0; s_ < 2; ++s_) { float t1[8], t2[8]; unpack8(qraw[s_], t1); unpack8(qraw[s_ + 2], t2); float o1[8], o2[8];
#pragma unroll
              for (int j = 0; j < 8; ++j) { const unsigned cw_ = qcs[s_][j >> 2][j & 3]; const f32x2v c = (f32x2v){bflo(cw_), bfhi(cw_)}; o1[j] = t1[j] * c.x - t2[j] * c.y; o2[j] = t2[j] * c.x + t1[j] * c.y; }
              qf[s_] = __builtin_bit_cast(bf16x8v_, (v4u){cvtpk_(o1[0], o1[1]), cvtpk_(o1[2], o1[3]), cvtpk_(o1[4], o1[5]), cvtpk_(o1[6], o1[7])});
              qf[s_ + 2] = __builtin_bit_cast(bf16x8v_, (v4u){cvtpk_(o2[0], o2[1]), cvtpk_(o2[2], o2[3]), cvtpk_(o2[4], o2[5]), cvtpk_(o2[6], o2[7])}); } }
        float fa[4], fb[4];
#pragma unroll
        for (int i = 0; i < 4; ++i) { fa[i] = __builtin_amdgcn_exp2f(-(float)(i + 4 * h5) * l2g); fb[i] = __builtin_amdgcn_exp2f(-(float)(8 * i) * l2g); }
        const float Ec = __builtin_amdgcn_exp2f((float)l31 * l2g);
        f32x16v_ oacc[2];
#pragma unroll
        for (int dvt = 0; dvt < 2; ++dvt)
#pragma unroll
            for (int r = 0; r < 16; ++r) oacc[dvt][r] = 0.f;
#pragma unroll 1
        for (int mt = 0; mt <= ct; ++mt) {
            f32x16v_ sacc;
#pragma unroll
            for (int r = 0; r < 16; ++r) sacc[r] = 0.f;
#pragma unroll
            for (int s_ = 0; s_ < 4; ++s_) { const bf16x8v_ kf = *(const LAS bf16x8v_*)(Ks + (32 * mt + l31) * 72 + 16 * s_ + 8 * h5); sacc = __builtin_amdgcn_mfma_f32_32x32x16_bf16(kf, qf[s_], sacc, 0, 0, 0); }
            const float TE = __builtin_amdgcn_exp2f((float)(32 * (ct - mt)) * l2g) * Ec; const bool diag = (mt == ct);
#pragma unroll
            for (int r = 0; r < 16; ++r) { float v = sacc[r] * (TE * fb[r >> 2]) * fa[r & 3]; if (diag && mrow(r, h5) > l31) v = 0.f; sacc[r] = v; }
#pragma unroll
            for (int s2 = 0; s2 < 2; ++s2) {
                const bf16x8v_ pf = __builtin_bit_cast(bf16x8v_, (v4u){cvtpk_(sacc[8 * s2 + 0], sacc[8 * s2 + 1]), cvtpk_(sacc[8 * s2 + 2], sacc[8 * s2 + 3]), cvtpk_(sacc[8 * s2 + 4], sacc[8 * s2 + 5]), cvtpk_(sacc[8 * s2 + 6], sacc[8 * s2 + 7])});
#pragma unroll
                for (int dvt = 0; dvt < 2; ++dvt) { const LAS unsigned short* vp_ = Vt + (64 * dvh + 32 * dvt + l31) * 132 + 32 * mt + 16 * s2 + 4 * h5;
                    const unsigned long long lo = *(const LAS unsigned long long*)vp_, hi = *(const LAS unsigned long long*)(vp_ + 8);
                    oacc[dvt] = __builtin_amdgcn_mfma_f32_32x32x16_bf16(__builtin_bit_cast(bf16x8v_, (v4u){(unsigned)lo, (unsigned)(lo >> 32), (unsigned)hi, (unsigned)(hi >> 32)}), pf, oacc[dvt], 0, 0, 0); }
            }
        }
        const int etok = tid >> 2, eq = tid & 3;
        v4u rgv[4], gav[4], mwv[4]; f32x4 gnv[4][2];
        { const size_t et = (size_t)tok0 + etok; const int ch0 = h * 128 + 32 * eq;
#pragma unroll
          for (int i = 0; i < 4; ++i) { rgv[i] = *(const GAS v4u*)(projA + et * NA + PA_RG + ch0 + 8 * i); gav[i] = *(const GAS v4u*)(projA + et * NA + PA_GA + ch0 + 8 * i); mwv[i] = *(const GAS v4u*)(merged + et * D + ch0 + 8 * i);
              gnv[i][0] = *(const GAS f32x4*)(gn_g + ch0 + 8 * i); gnv[i][1] = *(const GAS f32x4*)(gn_g + ch0 + 8 * i + 4); } }
        {
            const float qw_ = __builtin_amdgcn_exp2f((float)(32 * ct + l31 + 1) * l2g);
#pragma unroll
            for (int dvt = 0; dvt < 2; ++dvt) { f32x16v_ cacc;
#pragma unroll
                for (int r = 0; r < 16; ++r) cacc[r] = 0.f;
#pragma unroll
                for (int s_ = 0; s_ < 4; ++s_) { const bf16x8v_ sf = *(const LAS bf16x8v_*)(St + (64 * dvh + 32 * dvt + l31) * 72 + 16 * s_ + 8 * h5); cacc = __builtin_amdgcn_mfma_f32_32x32x16_bf16(sf, qf[s_], cacc, 0, 0, 0); }
#pragma unroll
                for (int r = 0; r < 16; ++r) oacc[dvt][r] += cacc[r] * qw_; }
        }
        float s1 = 0.f, s2 = 0.f;
#pragma unroll
        for (int dvt = 0; dvt < 2; ++dvt)
#pragma unroll
            for (int r = 0; r < 16; ++r) { const float v = oacc[dvt][r]; s1 += v; s2 += v * v; }
        s1 += __shfl_xor(s1, 32); s2 += __shfl_xor(s2, 32);
        if (h5 == 0) { Xs[(dvh * 128 + 32 * ct + l31) * 2] = s1; Xs[(dvh * 128 + 32 * ct + l31) * 2 + 1] = s2; }
        LDS_BARRIER();
        { LAS float* Ot = (LAS float*)lds;
#pragma unroll
          for (int dvt = 0; dvt < 2; ++dvt)
#pragma unroll
              for (int g_ = 0; g_ < 4; ++g_) *(LAS f32x4*)(Ot + (32 * ct + l31) * 132 + 64 * dvh + 32 * dvt + 8 * g_ + 4 * h5) = (f32x4){oacc[dvt][4 * g_ + 0], oacc[dvt][4 * g_ + 1], oacc[dvt][4 * g_ + 2], oacc[dvt][4 * g_ + 3]};
          LDS_BARRIER();
          const float t1_ = Xs[etok * 2] + Xs[(128 + etok) * 2], t2_ = Xs[etok * 2 + 1] + Xs[(128 + etok) * 2 + 1];
          const float mu = t1_ * (1.f / 128.f); const float var = fmaxf(t2_ * (1.f / 128.f) - mu * mu, 0.f); const float rs = rsqrtf(var + EPS);
          const size_t et = (size_t)tok0 + etok; const int ch0 = h * 128 + 32 * eq; bf16* mp = merged + et * D + ch0;
#pragma unroll
          for (int i = 0; i < 4; ++i) { const f32x4 oa = *(const LAS f32x4*)(Ot + etok * 132 + 32 * eq + 8 * i), ob = *(const LAS f32x4*)(Ot + etok * 132 + 32 * eq + 8 * i + 4);
              const f32x4 ga_ = gnv[i][0], gb_ = gnv[i][1];
              float rgf[8], gaf[8], mwf[8]; unpack8(rgv[i], rgf); unpack8(gav[i], gaf); unpack8(mwv[i], mwf);
              float y[8];
#pragma unroll
              for (int j = 0; j < 4; ++j) { y[j] = (oa[j] - mu) * rs * ga_[j] * siluf_(rgf[j]) * sigmoidf_(gaf[j]) + mwf[j]; y[4 + j] = (ob[j] - mu) * rs * gb_[j] * siluf_(rgf[4 + j]) * sigmoidf_(gaf[4 + j]) + mwf[4 + j]; }
              *(GAS v4u*)(mp + 8 * i) = (v4u){cvtpk_(y[0], y[1]), cvtpk_(y[2], y[3]), cvtpk_(y[4], y[5]), cvtpk_(y[6], y[7])}; } }
        LDS_BARRIER();
    }
#undef R3_LOAD
}

template <int N, int K, int J> __device__ __forceinline__ void bitonic_step(float (&a)[N]) {
#pragma unroll
    for (int i = 0; i < N; ++i) { const int l = i ^ J; if (l > i) { const bool up = ((i & K) == 0); const float lo = fminf(a[i], a[l]), hi = fmaxf(a[i], a[l]); a[i] = up ? hi : lo; a[l] = up ? lo : hi; } }
}
__device__ __forceinline__ void sort16_desc(float (&a)[16]) {
#define CE_(i, j) { const float hi_ = fmaxf(a[i], a[j]), lo_ = fminf(a[i], a[j]); a[i] = hi_; a[j] = lo_; }
    CE_(0, 13) CE_(1, 12) CE_(2, 15) CE_(3, 14) CE_(4, 8) CE_(5, 6) CE_(7, 11) CE_(9, 10)
    CE_(0, 5) CE_(1, 7) CE_(2, 9) CE_(3, 4) CE_(6, 13) CE_(8, 14) CE_(10, 15) CE_(11, 12)
    CE_(0, 1) CE_(2, 3) CE_(4, 5) CE_(6, 8) CE_(7, 9) CE_(10, 11) CE_(12, 13) CE_(14, 15)
    CE_(0, 2) CE_(1, 3) CE_(4, 10) CE_(5, 11) CE_(6, 7) CE_(8, 9) CE_(12, 14) CE_(13, 15)
    CE_(1, 2) CE_(3, 12) CE_(4, 6) CE_(5, 7) CE_(8, 10) CE_(9, 11) CE_(13, 14)
    CE_(1, 4) CE_(2, 6) CE_(5, 8) CE_(7, 10) CE_(9, 13) CE_(11, 14)
    CE_(2, 4) CE_(3, 6) CE_(9, 12) CE_(11, 13)
    CE_(3, 5) CE_(6, 8) CE_(7, 9) CE_(10, 12)
    CE_(3, 4) CE_(5, 6) CE_(7, 8) CE_(9, 10) CE_(11, 12)
    CE_(6, 7) CE_(8, 9)
#undef CE_
}
__device__ __forceinline__ void merge16_desc(float (&a)[16]) { bitonic_step<16, 16, 8>(a); bitonic_step<16, 16, 4>(a); bitonic_step<16, 16, 2>(a); bitonic_step<16, 16, 1>(a); }
__device__ __forceinline__ void top16_merge(float (&a)[16], const float (&b)[16]) {
#pragma unroll
    for (int i = 0; i < 16; ++i) a[i] = fmaxf(a[i], b[15 - i]);
    merge16_desc(a);
}
__device__ __forceinline__ void top16_xlane(float (&a)[16]) {
    float b[16];
#pragma unroll
    for (int i = 0; i < 16; ++i) b[i] = __shfl_xor(a[i], 32);
    top16_merge(a, b);
}
typedef float f32x16v __attribute__((ext_vector_type(16)));
typedef short bf16x8v __attribute__((ext_vector_type(8)));
__device__ __forceinline__ void peer_scores_top16(const LAS unsigned short* Ks, const bf16x8v (&qfr)[8]  , float (&top)[16], int lane) {
    f32x16v acc[4];
#pragma unroll
    for (int t = 0; t < 4; ++t)
#pragma unroll
        for (int r = 0; r < 16; ++r) acc[t][r] = 0.f;
    const LAS unsigned short* kp = Ks + (lane & 31) * 136 + 8 * (lane >> 5);
#pragma unroll
    for (int s_ = 0; s_ < 8; ++s_) {
#pragma unroll
        for (int t = 0; t < 4; ++t) { const bf16x8v kf = *(const LAS bf16x8v*)(kp + t * 32 * 136 + 16 * s_); acc[t] = __builtin_amdgcn_mfma_f32_32x32x16_bf16(kf, qfr[s_], acc[t], 0, 0, 0); } }
    float lst[4][16];
#pragma unroll
    for (int t = 0; t < 4; ++t) {
#pragma unroll
        for (int r = 0; r < 16; ++r) { const unsigned key = (unsigned)(32 * t + (r & 3) + 8 * (r >> 2) + 4 * (lane >> 5)); const float xf_ = acc[t][r];
            lst[t][r] = __builtin_bit_cast(float, (__builtin_bit_cast(unsigned, xf_) & ~0x7Fu) | key); }
        sort16_desc(lst[t]);
    }
    top16_merge(lst[0], lst[1]); top16_merge(lst[2], lst[3]); top16_merge(lst[0], lst[2]);
#pragma unroll
    for (int i = 0; i < 16; ++i) top[i] = lst[0][i];
    top16_xlane(top);
}
__device__ __forceinline__ void phase_peer_topk2(const bf16* qp, const bf16* k1b, const bf16* k2b, int* idxo, float* gateo, LAS unsigned char* lds, int vcu, int G, int tid) {
    const int lane = tid & 63, wave = __builtin_amdgcn_readfirstlane(tid >> 6);
    LAS unsigned short* K1s = (LAS unsigned short*)lds; LAS unsigned short* K2s = (LAS unsigned short*)(lds + 34816);
    const int h5 = lane >> 5;
    int hcur = -1;
    for (int u = vcu; u < 1024; u += G) {
        const int h = u & 7, tb = u >> 3;
        if (h != hcur) {
            __syncthreads();
            v4u kk1[4], kk2[4];
#pragma unroll
            for (int i = 0; i < 4; ++i) { const int idx = tid + NTHR * i, row = idx >> 4, c8 = idx & 15;
                kk1[i] = *(const GAS v4u*)(k1b + ((size_t)h * 128 + row) * 128 + c8 * 8); kk2[i] = *(const GAS v4u*)(k2b + ((size_t)h * 128 + row) * 128 + c8 * 8); }
            asm volatile("" ::: "memory");
#pragma unroll
            for (int i = 0; i < 4; ++i) { const int idx = tid + NTHR * i, row = idx >> 4, c8 = idx & 15;
                *(LAS v4u*)(K1s + row * 136 + c8 * 8) = kk1[i]; *(LAS v4u*)(K2s + row * 136 + c8 * 8) = kk2[i]; }
            __syncthreads(); hcur = h;
        }
        const size_t tok = (size_t)tb * 256 + wave * 32 + (lane & 31);
        const bf16* qrow = qp + tok * NQP + h * 256 + 8 * h5;
        bf16x8v qa[8], qb[8];
#pragma unroll
        for (int s_ = 0; s_ < 8; ++s_) { qa[s_] = *(const GAS bf16x8v*)(qrow + 16 * s_); qb[s_] = *(const GAS bf16x8v*)(qrow + 128 + 16 * s_); }
        float v1[16], v2[16];
        peer_scores_top16(K1s, qa, v1, lane);
        peer_scores_top16(K2s, qb, v2, lane);
        float p[16], q[16]; unsigned pid[16], qid[16];
#pragma unroll
        for (int i = 0; i < 16; ++i) { const float a1_ = v1[i], a2_ = v2[i]; p[i] = h5 ? a2_ : a1_; q[i] = h5 ? a1_ : a2_;
            pid[i] = (__builtin_bit_cast(unsigned, p[i]) & 0x7Fu) << (h5 ? 0 : 7); qid[i] = (__builtin_bit_cast(unsigned, q[i]) & 0x7Fu) << (h5 ? 7 : 0); }
        float c0[16], c1[16]; const float NEGV = -3.0e38f;
#pragma unroll
        for (int i = 0; i < 16; ++i) { c0[i] = NEGV; c1[i] = NEGV; }
        {
            constexpr int NP = 27; constexpr int PA[NP] = {0, 0, 0, 0, 0, 0, 0, 0, 0, 0, 0, 0, 0, 0, 0, 0, 1, 1, 1, 1, 1, 1, 1, 2, 2, 2, 3}; constexpr int PB[NP] = {0, 1, 2, 3, 4, 5, 6, 7, 8, 9, 10, 11, 12, 13, 14, 15, 1, 2, 3, 4, 5, 6, 7, 2, 3, 4, 3};
#pragma unroll
            for (int n = 0; n < NP; ++n) {
                float sv_ = p[PA[n]] + q[PB[n]];
                sv_ = __builtin_bit_cast(float, (__builtin_bit_cast(unsigned, sv_) & ~0x3FFFu) | pid[PA[n]] | qid[PB[n]]);
                if (PA[n] == PB[n]) sv_ = h5 ? NEGV : sv_;
                if (n < 16) c0[n] = sv_; else c1[n - 16] = sv_;
            }
        }
        sort16_desc(c0); sort16_desc(c1); top16_merge(c0, c1); top16_xlane(c0);
        float val[16]; float sm = 0.f;
        { const float mx = __builtin_bit_cast(float, (__builtin_bit_cast(unsigned, c0[0]) & ~0x3FFFu) | 0x2000u);
#pragma unroll
          for (int i = 0; i < 16; ++i) { const float vv = __builtin_bit_cast(float, (__builtin_bit_cast(unsigned, c0[i]) & ~0x3FFFu) | 0x2000u); val[i] = __expf(vv - mx); sm += val[i]; } }
        const float inv = 1.f / sm;
        v4u oi[2]; f32x4 og[2];
#pragma unroll
        for (int k = 0; k < 8; ++k) { const float cl_ = c0[k], ch_ = c0[8 + k], vl_ = val[k], vh_ = val[8 + k]; const float cc = h5 ? ch_ : cl_; const float gg = (h5 ? vh_ : vl_) * inv;
            oi[k >> 2][k & 3] = __builtin_bit_cast(unsigned, cc) & 0x3FFFu; og[k >> 2][k & 3] = gg; }
        int* ip = idxo + tok * 128 + h * 16 + 8 * h5; float* gp = gateo + tok * 128 + h * 16 + 8 * h5;
        *(GAS v4u*)ip = oi[0]; *(GAS v4u*)(ip + 4) = oi[1]; *(GAS f32x4*)gp = og[0]; *(GAS f32x4*)(gp + 4) = og[1];
    }
    __syncthreads();
}


__device__ __forceinline__ void cvt_rows_fp8(const float* src, unsigned char* dst, float* inv_scale, int vcu, int G, int tid) {
    const int lane = tid & 63, wave = __builtin_amdgcn_readfirstlane(tid >> 6);
    const int gw = vcu * NWAVES + wave, NGW = G * NWAVES;
    constexpr int RI = 4;
    for (int row0 = gw; row0 < NEXP; row0 += NGW * RI) {
        f32x4 v[RI][4]; float m[RI];
#pragma unroll
        for (int r = 0; r < RI; ++r) { const int row = row0 + r * NGW; const GAS f32x4* p = (const GAS f32x4*)(src + (size_t)(row < NEXP ? row : gw) * D + 16 * lane);
#pragma unroll
            for (int j = 0; j < 4; ++j) v[r][j] = p[j]; }
#pragma unroll
        for (int r = 0; r < RI; ++r) { float a = 0.f;
#pragma unroll
            for (int j = 0; j < 4; ++j) a = fmaxf(a, fmaxf(fmaxf(fabsf(v[r][j].x), fabsf(v[r][j].y)), fmaxf(fabsf(v[r][j].z), fabsf(v[r][j].w))));
            m[r] = a; }
#pragma unroll
        for (int r = 0; r < RI; ++r) m[r] = wave_max(m[r]);
#pragma unroll
        for (int r = 0; r < RI; ++r) { const int row = row0 + r * NGW; if (row < NEXP) {
            const int e = (int)((__builtin_bit_cast(unsigned, m[r]) >> 23) & 0xffu) - 127;
            const bool ok = (m[r] > 1e-30f);
            const float sc = ok ? __builtin_bit_cast(float, (unsigned)(127 + 7 - e) << 23) : 1.f, inv = ok ? __builtin_bit_cast(float, (unsigned)(127 - 7 + e) << 23) : 1.f;
            v4u o;
#pragma unroll
            for (int j = 0; j < 4; ++j) { int w = __builtin_amdgcn_cvt_pk_fp8_f32(v[r][j].x * sc, v[r][j].y * sc, 0, false); w = __builtin_amdgcn_cvt_pk_fp8_f32(v[r][j].z * sc, v[r][j].w * sc, w, true); o[j] = (unsigned)w; }
            *(GAS v4u*)(dst + (size_t)row * D + 16 * lane) = o;
            if (lane == 0) inv_scale[row] = inv; } }
    }
}
__device__ __forceinline__ void cvt_rows_i8(const float* src, unsigned char* dst, float* inv_scale, int vcu, int G, int tid) {
    const int lane = tid & 63, wave = __builtin_amdgcn_readfirstlane(tid >> 6);
    const int gw = vcu * NWAVES + wave, NGW = G * NWAVES;
    constexpr int RI = 4;
    for (int row0 = gw; row0 < NEXP; row0 += NGW * RI) {
        f32x4 v[RI][4]; float m[RI];
#pragma unroll
        for (int r = 0; r < RI; ++r) { const int row = row0 + r * NGW; const GAS f32x4* p = (const GAS f32x4*)(src + (size_t)(row < NEXP ? row : gw) * D + 16 * lane);
#pragma unroll
            for (int j = 0; j < 4; ++j) v[r][j] = p[j]; }
#pragma unroll
        for (int r = 0; r < RI; ++r) { float a = 0.f;
#pragma unroll
            for (int j = 0; j < 4; ++j) a = fmaxf(a, fmaxf(fmaxf(fabsf(v[r][j].x), fabsf(v[r][j].y)), fmaxf(fabsf(v[r][j].z), fabsf(v[r][j].w))));
            m[r] = a; }
#pragma unroll
        for (int r = 0; r < RI; ++r) m[r] = wave_max(m[r]);
#pragma unroll
        for (int r = 0; r < RI; ++r) { const int row = row0 + r * NGW; if (row < NEXP) {
            const bool ok = (m[r] > 1e-30f);
            const float sc = ok ? 127.f / m[r] : 1.f, inv = ok ? m[r] * (1.f / 127.f) : 1.f;
            v4u o;
#pragma unroll
            for (int j = 0; j < 4; ++j) { const int q0 = (int)rintf(v[r][j].x * sc), q1 = (int)rintf(v[r][j].y * sc), q2 = (int)rintf(v[r][j].z * sc), q3 = (int)rintf(v[r][j].w * sc);
                o[j] = ((unsigned)q0 & 0xffu) | (((unsigned)q1 & 0xffu) << 8) | (((unsigned)q2 & 0xffu) << 16) | ((unsigned)q3 << 24); }
            *(GAS v4u*)(dst + (size_t)row * D + 16 * lane) = o;
            if (lane == 0) inv_scale[row] = inv; } }
    }
}
__device__ __forceinline__ void fp8x16_to_f32(const v4u r, f32x2v* f) {
#pragma unroll
    for (int j = 0; j < 4; ++j) { f[2 * j] = __builtin_amdgcn_cvt_pk_f32_fp8((int)r[j], false); f[2 * j + 1] = __builtin_amdgcn_cvt_pk_f32_fp8((int)r[j], true); }
}
__device__ __forceinline__ float erf_as(float x) {
    const float ax = fabsf(x), t = __builtin_amdgcn_rcpf(fmaf(0.3275911f, ax, 1.f));
    const float p = t * fmaf(t, fmaf(t, fmaf(t, fmaf(t, 1.061405429f, -1.453152027f), 1.421413741f), -0.284496736f), 0.254829592f);
    const float r = 1.f - p * __builtin_amdgcn_exp2f(-ax * ax * 1.4426950408889634f);
    return copysignf(r, x);
}
constexpr int GT = 6;
__device__ __forceinline__ float swap_add32(float lo, float hi) { const v2u_ s = __builtin_amdgcn_permlane32_swap(__builtin_bit_cast(unsigned, lo), __builtin_bit_cast(unsigned, hi), false, false); const unsigned a_ = s.x, b_ = s.y; return __builtin_bit_cast(float, a_) + __builtin_bit_cast(float, b_); }
__device__ __forceinline__ float swap_add16(float lo, float hi) { const v2u_ s = __builtin_amdgcn_permlane16_swap(__builtin_bit_cast(unsigned, lo), __builtin_bit_cast(unsigned, hi), false, false); const unsigned a_ = s.x, b_ = s.y; return __builtin_bit_cast(float, a_) + __builtin_bit_cast(float, b_); }
template <int W, int LB> __device__ __forceinline__ void bfly8_step(float (&part)[8], int lane) {
    const bool up = (lane & LB) != 0;
#pragma unroll
    for (int j = 0; j < W; ++j) { const float lo = part[j], hi = part[j + W]; const float send = up ? lo : hi, keep = up ? hi : lo; part[j] = keep + __shfl_xor(send, LB); }
}
__device__ __forceinline__ void phase_peer_gather_lp(const bf16* xn2, const int* idx, const float* gate, const unsigned char* ub, const unsigned char* vb, const float* su, const float* sv,
                                                     bf16* x, float* outf, const float* g2, bool last, const float* ng, const float* nsc, const float* nsh, bf16* xn_next, LAS unsigned char* lds, int vcu, int G, int tid) {
    const int lane = tid & 63, wave = __builtin_amdgcn_readfirstlane(tid >> 6);
    const int gw = vcu * NWAVES + wave, NGW = G * NWAVES;
    constexpr int WB = GT * 1024 + GT * 512;
    LAS int* SE = (LAS int*)(lds + wave * WB); LAS float* SG = (LAS float*)(lds + wave * WB + GT * 512); LAS float* RED = (LAS float*)(lds + wave * WB + GT * 1024);
    const int jj = ((lane >> 5) & 1) * 4 + ((lane >> 4) & 1) * 2 + ((lane >> 3) & 1);
    const unsigned long long below = (1ull << lane) - 1ull;
    const int TPW = M / NGW;
    for (int tb = 0; tb * GT < TPW; ++tb) {
        const int nt = (TPW - tb * GT < GT) ? TPW - tb * GT : GT;
        v4u hp[GT][2]; f32x2v y2[GT][8];
#pragma unroll
        for (int t = 0; t < GT; ++t) { hp[t][0] = (v4u){0u, 0u, 0u, 0u}; hp[t][1] = hp[t][0]; }
#pragma unroll
        for (int t = 0; t < GT; ++t) if (t < nt) {
            const int tok = gw + (tb * GT + t) * NGW;
            int ls = lane; asm volatile("" : "+v"(ls));
            { const bf16* hr = xn2 + (size_t)tok * D + 16 * ls; hp[t][0] = *(const GAS v4u*)hr; hp[t][1] = *(const GAS v4u*)(hr + 8); }
            const int e0 = idx[(size_t)tok * 128 + ls], e1 = idx[(size_t)tok * 128 + 64 + ls];
            const float g0 = gate[(size_t)tok * 128 + ls], g1 = gate[(size_t)tok * 128 + 64 + ls];
            {
                const int k0 = e0 >> 10, k1 = e1 >> 10;
                unsigned long long m0 = ~0ull, m1 = ~0ull, x10 = ~0ull;
#pragma unroll
                for (int bb = 0; bb < 4; ++bb) { const bool b0 = (k0 >> bb) & 1, b1 = (k1 >> bb) & 1; const unsigned long long B0 = __ballot(b0), B1 = __ballot(b1);
                    m0 &= b0 ? B0 : ~B0; m1 &= b1 ? B1 : ~B1; x10 &= b1 ? B0 : ~B0; }
                const int r0 = __popcll(m0 & below), c0 = __popcll(m0), r1 = __popcll(m1 & below), c1 = __popcll(m1), c01 = __popcll(x10);
                LAS int* H = (LAS int*)(RED + t * 128);
                if (lane < 32) H[lane] = 0;
                if (r0 == 0) H[k0] = c0;
                if (r1 == 0) H[16 + k1] = c1;
                const int tot = H[lane & 15] + H[16 + (lane & 15)];
                asm volatile("s_waitcnt lgkmcnt(0)" ::: "memory");
                int inc = tot;
                inc += __builtin_amdgcn_update_dpp(0, inc, 0x111, 0xf, 0xf, true); inc += __builtin_amdgcn_update_dpp(0, inc, 0x112, 0xf, 0xf, true);
                inc += __builtin_amdgcn_update_dpp(0, inc, 0x114, 0xf, 0xf, true); inc += __builtin_amdgcn_update_dpp(0, inc, 0x118, 0xf, 0xf, true);
                if (lane < 16) H[32 + lane] = inc - tot;
                const int pos0 = H[32 + k0] + r0, pos1 = H[32 + k1] + c01 + r1;
                asm volatile("s_waitcnt lgkmcnt(0)" ::: "memory");
                SE[t * 128 + pos0] = e0; SG[t * 128 + pos0] = g0; SE[t * 128 + pos1] = e1; SG[t * 128 + pos1] = g1;
            }
        }
        asm volatile("s_waitcnt lgkmcnt(0)" ::: "memory");
        int xh[GT][4], xl[GT][4]; float inv_sx[GT];
#pragma unroll
        for (int t = 0; t < GT; ++t) { float hf[16]; unpack8(hp[t][0], hf); unpack8(hp[t][1], hf + 8); float a_ = 0.f;
#pragma unroll
            for (int q = 0; q < 16; ++q) a_ = fmaxf(a_, fabsf(hf[q]));
            a_ = wave_max(a_);
            const bool ok = a_ > 1e-30f; const float sq = ok ? 127.f / a_ : 1.f; inv_sx[t] = ok ? a_ * (1.f / 127.f) : 1.f;
#pragma unroll
            for (int j = 0; j < 4; ++j) { unsigned ph = 0u, pl = 0u;
#pragma unroll
                for (int k = 0; k < 4; ++k) { const float xs = hf[4 * j + k] * sq; const float h_ = rintf(xs); const int hi = (int)h_, lo = (int)rintf((xs - h_) * 254.f);
                    ph |= ((unsigned)hi & 0xffu) << (8 * k); pl |= ((unsigned)lo & 0xffu) << (8 * k); }
                xh[t][j] = (int)ph; xl[t][j] = (int)pl; } }
#pragma unroll 1
        for (int c = 0; c < 16; ++c) {
            if ((c & 3) == 0) __builtin_amdgcn_s_barrier();
#pragma unroll
          for (int th = 0; th < GT; th += 2) if (th < nt) {
            v4u rr[2][8];
#pragma unroll
            for (int t2 = 0; t2 < 2; ++t2) { const int sel = SE[(th + t2) * 128 + 8 * c + (lane & 7)]; const int l0 = 0;
#pragma unroll
                for (int i = 0; i < 8; ++i) { const int e = rl_i(sel, l0 + i); rr[t2][i] = *(const GAS v4u*)(ub + (size_t)e * D + 16 * lane); } }
#pragma unroll
            for (int t2 = 0; t2 < 2; ++t2) { const int t = th + t2;
                float part[8];
#pragma unroll
                for (int i = 0; i < 8; ++i) { int ah = 0, al = 0;
#pragma unroll
                    for (int j = 0; j < 4; ++j) { const int w_ = (int)rr[t2][i][j]; ah = __builtin_amdgcn_sdot4(w_, xh[t][j], ah, false); al = __builtin_amdgcn_sdot4(w_, xl[t][j], al, false); }
                    part[i] = fmaf((float)al, 1.f / 254.f, (float)ah); }
#pragma unroll
                for (int j = 0; j < 4; ++j) part[j] = swap_add32(part[j], part[j + 4]);
                part[0] = swap_add16(part[0], part[2]); part[1] = swap_add16(part[1], part[3]);
                { const float a_ = part[0] + dpp_f<0x128>(part[0]), b_ = part[1] + dpp_f<0x128>(part[1]); part[0] = (lane & 8) ? b_ : a_; }
                float sd_ = part[0]; sd_ += dpp_f<0x141>(sd_); sd_ += dpp_f<0xB1>(sd_); sd_ += dpp_f<0x4E>(sd_);
                if ((lane & 7) == 0) RED[(t * 16 + c) * 8 + jj] = sd_;
            }
          }
        }
        asm volatile("s_waitcnt lgkmcnt(0)" ::: "memory");
        float scu0[GT], scu1[GT], scv0[GT], scv1[GT];
#pragma unroll
        for (int t = 0; t < GT; ++t) { scu0[t] = scu1[t] = scv0[t] = scv1[t] = 0.f; if (t < nt) { const int s0_ = SE[t * 128 + lane], s1_ = SE[t * 128 + 64 + lane]; scu0[t] = su[s0_]; scu1[t] = su[s1_]; scv0[t] = sv[s0_]; scv1[t] = sv[s1_]; } }
#pragma unroll
        for (int t = 0; t < GT; ++t) if (t < nt) {
            const float d0 = RED[t * 128 + lane] * scu0[t] * inv_sx[t], d1 = RED[t * 128 + 64 + lane] * scu1[t] * inv_sx[t];
            const float c0_ = 0.5f * d0 * (1.f + erf_as(d0 * 0.70710678118654752f)) * scv0[t] * SG[t * 128 + lane];
            const float c1_ = 0.5f * d1 * (1.f + erf_as(d1 * 0.70710678118654752f)) * scv1[t] * SG[t * 128 + 64 + lane];
            asm volatile("s_waitcnt lgkmcnt(0)" ::: "memory");
            RED[t * 128 + lane] = c0_; RED[t * 128 + 64 + lane] = c1_;
        }
        asm volatile("s_waitcnt lgkmcnt(0)" ::: "memory");
#pragma unroll
        for (int t = 0; t < GT; ++t)
#pragma unroll
            for (int j = 0; j < 8; ++j) y2[t][j] = (f32x2v){0.f, 0.f};
#pragma unroll 1
        for (int c = 0; c < 16; ++c) {
            if ((c & 3) == 0) __builtin_amdgcn_s_barrier();
#pragma unroll
          for (int th = 0; th < GT; th += 2) if (th < nt) {
            v4u rr[2][8];
#pragma unroll
            for (int t2 = 0; t2 < 2; ++t2) { const int sel = SE[(th + t2) * 128 + 8 * c + (lane & 7)]; const int l0 = 0;
#pragma unroll
                for (int i = 0; i < 8; ++i) { const int e = rl_i(sel, l0 + i); rr[t2][i] = *(const GAS v4u*)(vb + (size_t)e * D + 16 * lane); } }
#pragma unroll
            for (int t2 = 0; t2 < 2; ++t2) { const int t = th + t2;
                const float coef = RED[(t * 16 + c) * 8 + jj];
#pragma unroll
                for (int i = 0; i < 8; ++i) { f32x2v vf[8]; fp8x16_to_f32(rr[t2][i], vf); const float cf = rl_f(coef, 32 * ((i >> 2) & 1) + 16 * ((i >> 1) & 1) + 8 * (i & 1));
#pragma unroll
                    for (int q = 0; q < 8; ++q) y2[t][q] += vf[q] * cf; }
            }
          }
        }
        asm volatile("s_waitcnt lgkmcnt(0)" ::: "memory");
        int lt = lane; asm volatile("" : "+v"(lt));
#pragma unroll
        for (int t = 0; t < GT; ++t) if (t < nt) {
            const int tok = gw + (tb * GT + t) * NGW; const int b = tok >> 12;
            bf16* xr = x + (size_t)tok * XP + 16 * lt; const float* gr = g2 + (size_t)b * MODW + 16 * lt;
            const float* scp = nsc + (size_t)b * MODW + 16 * lt; const float* shp = nsh + (size_t)b * MODW + 16 * lt;
            const v4u xw0 = *(const GAS v4u*)xr, xw1 = *(const GAS v4u*)(xr + 8);
            f32x4 gav[4];
#pragma unroll
            for (int q = 0; q < 4; ++q) gav[q] = *(const GAS f32x4*)(gr + 4 * q);
            asm volatile("" ::: "memory");
            f32x4 xv[4]; float ss = 0.f;
            { float xf[16]; unpack8(xw0, xf); unpack8(xw1, xf + 8);
#pragma unroll
            for (int q = 0; q < 4; ++q) { const f32x4 xa = (f32x4){xf[4 * q], xf[4 * q + 1], xf[4 * q + 2], xf[4 * q + 3]};
                const f32x4 yy = (f32x4){y2[t][2 * q].x, y2[t][2 * q].y, y2[t][2 * q + 1].x, y2[t][2 * q + 1].y};
                xv[q] = xa + gav[q] * yy; ss += (xv[q].x * xv[q].x + xv[q].y * xv[q].y) + (xv[q].z * xv[q].z + xv[q].w * xv[q].w); } }
            if (last) {
                f32x4 ngv[4];
#pragma unroll
                for (int q = 0; q < 4; ++q) ngv[q] = *(const GAS f32x4*)(ng + 16 * lt + 4 * q);
                asm volatile("" ::: "memory");
                const float rstd = rsqrtf(wave_sum(ss) * (1.f / D) + EPS);
                float* orow = outf + (size_t)tok * D + 16 * lt;
#pragma unroll
                for (int q = 0; q < 4; ++q) *(GAS f32x4*)(orow + 4 * q) = xv[q] * rstd * ngv[q];
            } else {
                f32x4 ngv[4], scv_[4], shv_[4];
#pragma unroll
                for (int q = 0; q < 4; ++q) { ngv[q] = *(const GAS f32x4*)(ng + 16 * lt + 4 * q); scv_[q] = *(const GAS f32x4*)(scp + 4 * q); shv_[q] = *(const GAS f32x4*)(shp + 4 * q); }
                asm volatile("" ::: "memory");
                const float rstd = rsqrtf(wave_sum(ss) * (1.f / D) + EPS);
                bf16* orow = xn_next + (size_t)tok * D + 16 * lt;
                unsigned pk[8], px[8];
#pragma unroll
                for (int q = 0; q < 4; ++q) { px[2 * q] = pk2(xv[q].x, xv[q].y); px[2 * q + 1] = pk2(xv[q].z, xv[q].w);
                    const f32x4 hn = (xv[q] * rstd * ngv[q]) * (scv_[q] + 1.0f) + shv_[q]; pk[2 * q] = pk2(hn.x, hn.y); pk[2 * q + 1] = pk2(hn.z, hn.w); }
                *(GAS v4u*)xr = (v4u){px[0], px[1], px[2], px[3]}; *(GAS v4u*)(xr + 8) = (v4u){px[4], px[5], px[6], px[7]};
                *(GAS v4u*)orow = (v4u){pk[0], pk[1], pk[2], pk[3]}; *(GAS v4u*)(orow + 8) = (v4u){pk[4], pk[5], pk[6], pk[7]};
            }
        }
    }
}

constexpr int PH_PER_LAYER = 11, N_PHASES = 2 + DEPTH * PH_PER_LAYER;
#ifndef PHASE_MASK
#define PHASE_MASK 0xFFFF
#endif
#define PM(k) ((PHASE_MASK >> (k)) & 1)
#ifndef MK_PER_PHASE
#define MK_PER_PHASE 0
#endif
__global__ void __launch_bounds__(NTHR, 2) mk_fwd(Args args) {
    extern __shared__ __attribute__((aligned(16))) unsigned char lds_raw[];
    LAS unsigned char* lds = (LAS unsigned char*)lds_raw;
    const int tid0 = threadIdx.x;
    const int G = gridDim.x; const int bx = blockIdx.x; const int vcu = (G % 8 == 0) ? (bx % 8) * (G / 8) + bx / 8 : bx;
    for (int u = tid0; u < (LDS_BYTES - LDSCTL_OFF) / 4; u += NTHR) ((LAS unsigned*)(lds + LDSCTL_OFF))[u] = 0u;
    __syncthreads();
    XcdBarrier bar; bar.bar = (unsigned*)(args.ws + WS_CTL) + CW_BAR; bar.x = 0; bar.st = nullptr;
    if (!MK_PER_PHASE) bar = xcd_barrier_post((unsigned*)(args.ws + WS_CTL) + CW_BAR, (volatile LAS unsigned*)(lds + LDSCTL_OFF) + 8);
    for (int p = args.ph_lo; p < args.ph_hi; ++p) {
        int tid = tid0; asm volatile("" : "+v"(tid));
        unsigned char* ws = args.ws; asm volatile("" : "+s"(ws));
        float* modp = (float*)(ws + WS_MOD);
        int l = 0, r = -1;
        if (p >= 2) { l = (p - 2) / PH_PER_LAYER; r = (p - 2) % PH_PER_LAYER; }
        const float* modl = modp + (size_t)l * 8 * MODW;
        if (p == 0) { if (PM(0)) phase_prologue(args, lds, vcu, G, tid); }
        else if (p == 1 || r == 7) {
            if (PM(1)) {
                if (p == 1) phase_norm(args.in[0], args.in[5], modl + 1024, modl + 0, (bf16*)(ws + WS_XN), vcu, G, tid);
                else { phase_norm_b((const bf16*)args.out, args.in[6] + l * D, modl + 4096, modl + 3072, (bf16*)(ws + WS_XN), vcu, G, tid); cvt_rows_i8(args.in[14] + (size_t)l * NEXP * D, ws + WS_U8, (float*)(ws + WS_SU), vcu, G, tid);
                    cvt_rows_fp8(args.in[15] + (size_t)l * NEXP * D, ws + WS_V8, (float*)(ws + WS_SV), vcu, G, tid); }
            }
        }
        else if (r == 0 || r == 2 || r == 8) {
            if (PM(2)) {
                const bf16* Bt; int N; bf16* O;
                if (r == 0) { Bt = (const bf16*)(ws + WS_WIN) + (size_t)l * NIN * D + (size_t)NA * D; N = NB; O = (bf16*)(ws + WS_PROJ); }
                else if (r == 2) { Bt = (const bf16*)(ws + WS_WIN) + (size_t)l * NIN * D; N = NA; O = (bf16*)(ws + WS_PROJ); }
                else { Bt = (const bf16*)(ws + WS_WQ) + (size_t)l * NQP * D; N = NQP; O = (bf16*)(ws + WS_QP); }
                pg8::Gemm g{(const bf16*)(ws + WS_XN), Bt, M, N, D}; pg8::StaticOrder S; S.init(M, N, G, bx);
                pg8::EpiBf16 E{O, N};
                pg8::gemm_phase<pg8::EpiBf16, pg8::StaticOrder, PG8_ALIGN, PG8_SP2>(lds, g, S, E);
            }
        }
        else if (r == 1) { if (PM(3)) phase_swa_mfma((const bf16*)(ws + WS_PROJ), (const unsigned*)(ws + WS_ROPE_A), args.in[9] + l * 16, (bf16*)(ws + WS_MERGED), lds, vcu, G, tid); }
        else if (r == 3) { if (PM(4)) phase_ret_kv_mfma((const bf16*)(ws + WS_PROJ), (const unsigned*)(ws + WS_ROPE_R), (float*)(ws + WS_XN), lds, vcu, G, tid); }
        else if (r == 4) { if (PM(5)) phase_ret_scan2((const float*)(ws + WS_XN), (bf16*)(ws + WS_PREVT), vcu, G, tid); }
        else if (r == 5) { if (PM(6)) phase_ret_out_mfma((const bf16*)(ws + WS_PROJ), (const unsigned*)(ws + WS_ROPE_R), (const bf16*)(ws + WS_PREVT), args.in[8] + l * D, (bf16*)(ws + WS_MERGED), lds, vcu, G, tid); }
        else if (r == 6) {
            if (PM(7)) {
                pg8::Gemm g{(const bf16*)(ws + WS_MERGED), (const bf16*)(ws + WS_WOUT) + (size_t)l * D * D, M, D, D}; pg8::StaticOrder S; S.init(M, D, G, bx);
                pg8::EpiResGateB E{l == 0 ? (const void*)args.in[0] : (const void*)args.out, l == 0 ? D : XP, l != 0, (pg8::bf16_t*)args.out, XP, modl + 2048, MODW};
                pg8::gemm_phase<pg8::EpiResGateB, pg8::StaticOrder, PG8_ALIGN, PG8_SP2>(lds, g, S, E);
            }
        }
        else if (r == 9) { if (PM(8)) phase_peer_topk2((const bf16*)(ws + WS_QP), (const bf16*)(ws + WS_K1) + (size_t)l * 8 * 128 * 128, (const bf16*)(ws + WS_K2) + (size_t)l * 8 * 128 * 128, (int*)(ws + WS_IDX), (float*)(ws + WS_GATE), lds, vcu, G, tid); }
        else {
            if (PM(9)) {
                const bool last = (l == DEPTH - 1);
                const float* modn = modp + (size_t)(last ? l : l + 1) * 8 * MODW;
                phase_peer_gather_lp((const bf16*)(ws + WS_XN), (const int*)(ws + WS_IDX), (const float*)(ws + WS_GATE), ws + WS_U8, ws + WS_V8, (const float*)(ws + WS_SU), (const float*)(ws + WS_SV), (bf16*)args.out, args.out, modl + 5120,
                                  last, last ? args.in[16] : args.in[5] + (l + 1) * D, modn + 1024, modn + 0, (bf16*)(ws + WS_XN), lds, vcu, G, tid);
            }
        }
        if (!MK_PER_PHASE && p + 1 < args.ph_hi) xcd_barrier(bar);
    }
}

extern "C" void kernel_launch(void* const* d_in, const int* in_sizes, int n_in, void* d_out, int out_size, void* d_ws, size_t ws_size, hipStream_t stream) {
    static int grid = 0;
    if (grid == 0) {
        if (n_in != 17 || in_sizes[0] != M * D || out_size != M * D || ws_size < WS_END) { fprintf(stderr, "kernel_launch: unexpected problem (n_in %d, in0 %d, out %d, ws %zu < %zu); nothing launched\n", n_in, n_in > 0 ? in_sizes[0] : -1, out_size, ws_size, (size_t)WS_END); grid = -1; return; }
        int dev = 0, cus = 0, per_cu = 0;
        if (hipGetDevice(&dev) != hipSuccess || hipDeviceGetAttribute(&cus, hipDeviceAttributeMultiprocessorCount, dev) != hipSuccess) { grid = -1; return; }
        if (hipFuncSetAttribute((const void*)mk_fwd, hipFuncAttributeMaxDynamicSharedMemorySize, LDS_BYTES) != hipSuccess) { fprintf(stderr, "kernel_launch: hipFuncSetAttribute failed\n"); grid = -1; return; }
        if (hipOccupancyMaxActiveBlocksPerMultiprocessor(&per_cu, (const void*)mk_fwd, NTHR, LDS_BYTES) != hipSuccess || per_cu < 1) { fprintf(stderr, "kernel_launch: occupancy query says %d blocks per CU; nothing launched\n", per_cu); (void)hipGetLastError(); grid = -1; return; }
        (void)hipGetLastError();
        if (cus != 256) { fprintf(stderr, "kernel_launch: built for a 256-CU device (MI355X), found %d CUs; nothing launched\n", cus); grid = -1; return; }
        grid = cus;
    }
    if (grid < 0) return;
    if (hipMemsetAsync((char*)d_ws + WS_CTL, 0, CTL_ZERO_BYTES, stream) != hipSuccess) return;
    Args a{};
    for (int i = 0; i < 17; ++i) a.in[i] = (const float*)d_in[i];
    a.out = (float*)d_out; a.ws = (unsigned char*)d_ws;
#if MK_PER_PHASE
    for (int p = 0; p < N_PHASES; ++p) { a.ph_lo = p; a.ph_hi = p + 1; a.li = 0; hipLaunchKernelGGL(mk_fwd, dim3(grid), dim3(NTHR), LDS_BYTES, stream, a); }
#else
    a.ph_lo = 0; a.ph_hi = N_PHASES; a.li = 0;
    hipLaunchKernelGGL(mk_fwd, dim3(grid), dim3(NTHR), LDS_BYTES, stream, a);
#endif
}
```
